# Optimizing an MI355X kernel written in HIP

```python
import jax
import jax.numpy as jnp
from jax import lax
import numpy as np


D_MODEL = 2048
BATCH = 4
SEQ = 4096
DEPTH = 4

PLE_DIM = 256
CONV_CH = 1024
CONV_K = 3
M_HEADS = 8
M_HD = 128
M_W = M_HEADS * M_HD
M_CHUNK = 64
A_QH = 16
A_KVH = 4
A_GROUP = A_QH // A_KVH
A_HD = 64
A_QW = A_QH * A_HD
A_KVW = A_KVH * A_HD
WINDOW = 128
A_BLOCK = 128
ROPE_THETA = 10000.0
N_BRANCH = 3
EPS = 1e-6

SPLIT_SIZES = (
    CONV_CH, CONV_CH, CONV_CH, CONV_CH,
    M_W, M_W, M_W, M_W, M_HEADS, M_HEADS, M_W,
    A_QW, A_KVW, A_KVW, A_QW,
    N_BRANCH * D_MODEL,
)
SPLIT_POINTS = [sum(SPLIT_SIZES[:i + 1]) for i in range(len(SPLIT_SIZES) - 1)]
IN_W = sum(SPLIT_SIZES)

kernel_name = 'hybrid_conv_mlstm_swa_gated_trunk'


def rmsnorm(x, g):
    xf = x.astype(jnp.float32)
    var = jnp.mean(xf * xf, axis=-1, keepdims=True)
    return (xf * lax.rsqrt(var + EPS) * g.astype(jnp.float32)).astype(x.dtype)


def rope(x, pos):
    hd = x.shape[-1]
    half = hd // 2
    inv = jnp.power(ROPE_THETA, -2.0 * jnp.arange(half, dtype=jnp.float32) / hd)
    ang = pos.astype(jnp.float32)[..., None] * inv
    cos = jnp.cos(ang)[:, :, None, :]
    sin = jnp.sin(ang)[:, :, None, :]
    xf = x.astype(jnp.float32)
    x1, x2 = xf[..., :half], xf[..., half:]
    return jnp.concatenate([x1 * cos - x2 * sin, x2 * cos + x1 * sin], axis=-1).astype(x.dtype)


def short_conv_mixer(b, c, u, w):
    v = c * u
    S = v.shape[1]
    vp = jnp.pad(v, ((0, 0), (CONV_K - 1, 0), (0, 0)))
    y = w[0] * vp[:, 0:S]
    for j in range(1, CONV_K):
        y = y + w[j] * vp[:, j:j + S]
    return b * y


def mlstm_chunkwise(q, k, v, i_pre, f_pre):
    Bsz, S = q.shape[0], q.shape[1]
    L = M_CHUNK
    nc = S // L
    f32 = jnp.float32

    def chunks(t):
        t = t.astype(f32).reshape((Bsz, nc, L) + t.shape[2:])
        return jnp.moveaxis(t, 3, 1)

    qc = chunks(q) * (M_HD ** -0.5)
    kc = chunks(k)
    vc = chunks(v)
    log_i = chunks(i_pre)
    log_f = jax.nn.log_sigmoid(chunks(f_pre))
    bcum = jnp.cumsum(log_f, axis=-1)
    b_last = bcum[..., -1]

    g = b_last[..., None] - bcum + log_i
    g_max = jnp.max(g, axis=-1)
    w_end = jnp.exp(g - g_max[..., None])
    C_loc = jnp.einsum('bhcl,bhcld,bhcle->bhcde', w_end, vc, kc)
    n_loc = jnp.einsum('bhcl,bhcle->bhce', w_end, kc)

    def step(carry, xs):
        C, n, m = carry
        Cl, nl, gm, bl = xs
        m_new = jnp.maximum(bl + m, gm)
        a = jnp.exp(bl + m - m_new)
        c = jnp.exp(gm - m_new)
        C_new = a[..., None, None] * C + c[..., None, None] * Cl
        n_new = a[..., None] * n + c[..., None] * nl
        return (C_new, n_new, m_new), (C, n, m)

    init = (jnp.zeros((Bsz, M_HEADS, M_HD, M_HD), f32),
            jnp.zeros((Bsz, M_HEADS, M_HD), f32),
            jnp.zeros((Bsz, M_HEADS), f32))
    xs = (jnp.moveaxis(C_loc, 2, 0), jnp.moveaxis(n_loc, 2, 0),
          jnp.moveaxis(g_max, 2, 0), jnp.moveaxis(b_last, 2, 0))
    _, (C_prev, n_prev, m_prev) = lax.scan(step, init, xs)
    C_prev = jnp.moveaxis(C_prev, 0, 2)
    n_prev = jnp.moveaxis(n_prev, 0, 2)
    m_prev = jnp.moveaxis(m_prev, 0, 2)

    causal = jnp.tril(jnp.ones((L, L), dtype=bool))
    D = bcum[..., :, None] - bcum[..., None, :] + log_i[..., None, :]
    D = jnp.where(causal, D, -jnp.inf)
    inter = bcum + m_prev[..., None]
    m = jnp.maximum(inter, jnp.max(D, axis=-1))
    Sw = jnp.einsum('bhcld,bhcsd->bhcls', qc, kc) * jnp.exp(D - m[..., None])
    w_inter = jnp.exp(inter - m)
    num = (jnp.einsum('bhcls,bhcsd->bhcld', Sw, vc)
           + w_inter[..., None] * jnp.einsum('bhcle,bhcde->bhcld', qc, C_prev))
    den = jnp.sum(Sw, axis=-1) + w_inter * jnp.einsum('bhcle,bhce->bhcl', qc, n_prev)
    h = num / jnp.maximum(jnp.abs(den), jnp.exp(-m))[..., None]
    h = jnp.moveaxis(h, 1, 3).reshape(Bsz, S, M_W)
    return h.astype(q.dtype)


def sliding_window_attention(q, k, v, sinks):
    Bsz, S = q.shape[0], q.shape[1]
    nb = S // A_BLOCK
    f32 = jnp.float32
    qb = q.astype(f32).reshape(Bsz, nb, A_BLOCK, A_KVH, A_GROUP, A_HD)

    def banded(t):
        tb = t.astype(f32).reshape(Bsz, nb, A_BLOCK, A_KVH, A_HD)
        prev = jnp.pad(tb, ((0, 0), (1, 0), (0, 0), (0, 0), (0, 0)))[:, :-1]
        return jnp.concatenate([prev, tb], axis=2)

    kb = banded(k)
    vb = banded(v)
    s = jnp.einsum('bnqhgd,bnkhd->bnhgqk', qb, kb) * (A_HD ** -0.5)
    qi = jnp.arange(A_BLOCK)[:, None]
    ki = jnp.arange(2 * A_BLOCK)[None, :]
    rel = qi + A_BLOCK - ki
    blk = jnp.arange(nb)[:, None, None]
    valid = (rel >= 0) & (rel < WINDOW) & (blk * A_BLOCK + ki - A_BLOCK >= 0)
    s = jnp.where(valid[None, :, None, None], s, -jnp.inf)
    sink = sinks.astype(f32).reshape(A_KVH, A_GROUP)[None, None, :, :, None, None]
    sink = jnp.broadcast_to(sink, s.shape[:-1] + (1,))
    probs = jax.nn.softmax(jnp.concatenate([s, sink], axis=-1), axis=-1)[..., :-1]
    o = jnp.einsum('bnhgqk,bnkhd->bnqhgd', probs, vb)
    return o.reshape(Bsz, S, A_QW).astype(q.dtype)


def hybrid_layer(x, p_i, positions, w_in, conv_w, b_ig, b_fg, m_norm, sinks,
                 w_up_c, w_up_m, w_up_a, w_out, pre_g, post_g, w_ple, w_ple_gate, ple_g):
    Bsz, S, _ = x.shape
    h = rmsnorm(x, pre_g)
    z = h @ w_in
    (cb, cc, cx, cg, mq, mk, mv, mo, mi, mf, mg,
     aq, ak, av, ag, gates) = jnp.split(z, SPLIT_POINTS, axis=-1)

    y_c = short_conv_mixer(cb, cc, cx, conv_w) * jax.nn.silu(cg)

    hm = mlstm_chunkwise(mq.reshape(Bsz, S, M_HEADS, M_HD), mk.reshape(Bsz, S, M_HEADS, M_HD),
                         mv.reshape(Bsz, S, M_HEADS, M_HD), mi + b_ig, mf + b_fg)
    hm = rmsnorm(hm.reshape(Bsz, S, M_HEADS, M_HD), m_norm.reshape(M_HEADS, M_HD)).reshape(Bsz, S, M_W)
    y_m = hm * jax.nn.sigmoid(mo) * jax.nn.silu(mg)

    qa = rope(aq.reshape(Bsz, S, A_QH, A_HD), positions)
    ka = rope(ak.reshape(Bsz, S, A_KVH, A_HD), positions)
    va = av.reshape(Bsz, S, A_KVH, A_HD)
    y_a = sliding_window_attention(qa, ka, va, sinks) * jax.nn.silu(ag)

    gt = jax.nn.sigmoid(gates).reshape(Bsz, S, N_BRANCH, D_MODEL)
    merged = (gt[:, :, 0] * (y_c @ w_up_c) + gt[:, :, 1] * (y_m @ w_up_m)
              + gt[:, :, 2] * (y_a @ w_up_a))
    x = x + rmsnorm(merged @ w_out, post_g)

    e = p_i @ w_ple
    x = x + rmsnorm(jax.nn.sigmoid(x @ w_ple_gate) * e, ple_g)
    return x


def setup_inputs(seed: int = 0) -> dict:
    key = jax.random.key(seed)
    ks = jax.random.split(key, 20)
    f32 = jnp.float32

    def nrm(k, shape, scale):
        return jax.random.normal(k, shape, f32) * scale

    x = nrm(ks[0], (BATCH, SEQ, D_MODEL), 1.0)
    p = nrm(ks[1], (DEPTH, BATCH, SEQ, PLE_DIM), 1.0)
    offs = jax.random.randint(ks[2], (BATCH, 1), 0, 1024, dtype=jnp.int32)
    positions = offs + jnp.arange(SEQ, dtype=jnp.int32)[None, :]
    w_in = nrm(ks[3], (DEPTH, D_MODEL, IN_W), D_MODEL ** -0.5)
    conv_w = nrm(ks[4], (DEPTH, CONV_K, CONV_CH), CONV_K ** -0.5)
    b_igate = nrm(ks[5], (DEPTH, M_HEADS), 0.1)
    b_fgate = jnp.linspace(3.0, 6.0, M_HEADS, dtype=f32)[None, :] + nrm(ks[6], (DEPTH, M_HEADS), 0.01)
    mlstm_norm = 1.0 + nrm(ks[7], (DEPTH, M_W), 0.02)
    attn_sinks = nrm(ks[8], (DEPTH, A_QH), 0.5)
    w_up_conv = nrm(ks[9], (DEPTH, CONV_CH, D_MODEL), CONV_CH ** -0.5)
    w_up_mlstm = nrm(ks[10], (DEPTH, M_W, D_MODEL), M_W ** -0.5)
    w_up_attn = nrm(ks[11], (DEPTH, A_QW, D_MODEL), A_QW ** -0.5)
    w_out = nrm(ks[12], (DEPTH, D_MODEL, D_MODEL), D_MODEL ** -0.5)
    pre_norm = 1.0 + nrm(ks[13], (DEPTH, D_MODEL), 0.02)
    post_norm = 1.0 + nrm(ks[14], (DEPTH, D_MODEL), 0.02)
    w_ple = nrm(ks[15], (DEPTH, PLE_DIM, D_MODEL), PLE_DIM ** -0.5)
    w_ple_gate = nrm(ks[16], (DEPTH, D_MODEL, D_MODEL), D_MODEL ** -0.5)
    ple_norm = 1.0 + nrm(ks[17], (DEPTH, D_MODEL), 0.02)
    return {'x': x, 'p': p, 'positions': positions, 'w_in': w_in, 'conv_w': conv_w,
            'b_igate': b_igate, 'b_fgate': b_fgate, 'mlstm_norm': mlstm_norm,
            'attn_sinks': attn_sinks, 'w_up_conv': w_up_conv, 'w_up_mlstm': w_up_mlstm,
            'w_up_attn': w_up_attn, 'w_out': w_out, 'pre_norm': pre_norm,
            'post_norm': post_norm, 'w_ple': w_ple, 'w_ple_gate': w_ple_gate,
            'ple_norm': ple_norm}


def reference(x, p, positions, w_in, conv_w, b_igate, b_fgate, mlstm_norm, attn_sinks,
              w_up_conv, w_up_mlstm, w_up_attn, w_out, pre_norm, post_norm, w_ple,
              w_ple_gate, ple_norm):
    for i in range(DEPTH):
        x = hybrid_layer(x, p[i], positions, w_in[i], conv_w[i], b_igate[i], b_fgate[i],
                         mlstm_norm[i], attn_sinks[i], w_up_conv[i], w_up_mlstm[i],
                         w_up_attn[i], w_out[i], pre_norm[i], post_norm[i], w_ple[i],
                         w_ple_gate[i], ple_norm[i])
    return x
```

```cpp
#include <hip/hip_runtime.h>
#include <cstdio>
#include <cstdint>

#ifndef MK_ONE_LAUNCH
#define MK_ONE_LAUNCH 0
#endif
#ifndef NAIVE_ATTN
#define NAIVE_ATTN 1
#endif
#ifndef NAIVE_MLSTM
#define NAIVE_MLSTM 1
#endif

namespace pg8 {
#define PG8_LAS __attribute__((address_space(3)))
typedef unsigned short bf16_t;
typedef short bf16x8 __attribute__((ext_vector_type(8)));
typedef float f32x4 __attribute__((ext_vector_type(4)));
typedef unsigned u32x4 __attribute__((ext_vector_type(4)));
typedef unsigned u32x2 __attribute__((ext_vector_type(2)));
constexpr int BM = 256, BK = 64, HALF = 128, HTB = HALF * BK * 2, STAGE_BYTES = 8 * HTB, NXCD = 8, WGM = 8;

__host__ __device__ __forceinline__ int lds_byte(int r, int c) { const int st = (r >> 4) * 2 + (c >> 5), rr = r & 15, cc = c & 31, ob = rr * 64 + cc * 2; return st * 1024 + (ob ^ (((ob >> 9) & 1) << 5)); }
__host__ __device__ __forceinline__ void stage_rc(int b, int& R, int& C) { const int st = b / 1024, sb = b % 1024, swz = sb ^ (((sb >> 9) & 1) << 5); R = (st >> 1) * 16 + swz / 64; C = (st & 1) * 32 + (swz % 64) / 2; }
__host__ __device__ __forceinline__ int perm32(int rho) { const int n = rho >> 4, i = rho & 15; return 8 * (i >> 2) + 4 * n + (i & 3); }

struct Unit { int pm, pn, br; };
struct Gemm { const bf16_t* A; const bf16_t* Bt; size_t brA, brB; int M, N, K, nbr;
    __device__ __forceinline__ const char* a(int br) const { return (const char*)A + (size_t)br * brA; }
    __device__ __forceinline__ const char* b(int br) const { return (const char*)Bt + (size_t)br * brB; } };

struct StaticOrder {
    int nM, nN, nwg, G, c, nbr;
    __host__ __device__ void init(int M, int N, int G_, int c_, int nbr_) { nM = M / BM; nN = N / BM; nwg = nM * nN; G = G_; c = c_; nbr = nbr_; }
    __host__ __device__ bool next(int i, Unit& u) const {
        const int it = i / nbr; u.br = i - it * nbr;
        const long L = (long)it * G + c; if (L >= nwg) return false;
        int wgid = (int)L; { const int q = nwg / NXCD, r = nwg % NXCD, xcd = wgid % NXCD, off = wgid / NXCD; wgid = (xcd < r ? xcd * (q + 1) : r * (q + 1) + (xcd - r) * q) + off; }
        const int nig = WGM * nN, gid = wgid / nig, fm = gid * WGM, gsz = (nM - fm) < WGM ? (nM - fm) : WGM;
        u.pm = fm + ((wgid % nig) % gsz); u.pn = (wgid % nig) / gsz; return true;
    }
};

__device__ __forceinline__ unsigned cvt_pk_bf16(float lo, float hi) { unsigned r; asm volatile("v_cvt_pk_bf16_f32 %0, %1, %2" : "=v"(r) : "v"(lo), "v"(hi)); return r; }
__device__ __forceinline__ float bflo(unsigned w) { return __uint_as_float(w << 16); }
__device__ __forceinline__ float bfhi(unsigned w) { return __uint_as_float(w & 0xffff0000u); }

typedef f32x4 AccT[2][2][4][2];

struct EpiBf16 {
    static constexpr bool PERM = true;
    bf16_t* O; int ldc;
    __device__ __forceinline__ bool keep(const Unit&) const { return false; }
    __device__ __forceinline__ void operator()(AccT& acc, const Unit& u, int wr, int wc, int fr, int fq) const {
        const int row0 = u.pm * BM + wr * 64 + fr, col0 = u.pn * BM + wc * 32 + 8 * fq;
#pragma unroll
        for (int ai = 0; ai < 2; ++ai)
#pragma unroll
            for (int m = 0; m < 4; ++m) { bf16_t* rowp = O + (size_t)(row0 + ai * HALF + m * 16) * ldc + col0;
#pragma unroll
                for (int bj = 0; bj < 2; ++bj) { const f32x4 v0 = acc[ai][bj][m][0], v1 = acc[ai][bj][m][1];
                    u32x4 w; w.x = cvt_pk_bf16(v0[0], v0[1]); w.y = cvt_pk_bf16(v0[2], v0[3]); w.z = cvt_pk_bf16(v1[0], v1[1]); w.w = cvt_pk_bf16(v1[2], v1[3]);
                    *(u32x4*)(rowp + bj * HALF) = w; } }
    }
};
struct EpiF32 {
    static constexpr bool PERM = false;
    float* C; int ldc;
    __device__ __forceinline__ bool keep(const Unit&) const { return false; }
    __device__ __forceinline__ void operator()(AccT& acc, const Unit& u, int wr, int wc, int fr, int fq) const {
        const int row0 = u.pm * BM + wr * 64 + fr, col0 = u.pn * BM + wc * 32 + 4 * fq;
#pragma unroll
        for (int ai = 0; ai < 2; ++ai)
#pragma unroll
            for (int m = 0; m < 4; ++m) { float* rowp = C + (size_t)(row0 + ai * HALF + m * 16) * ldc + col0;
#pragma unroll
                for (int bj = 0; bj < 2; ++bj)
#pragma unroll
                    for (int n = 0; n < 2; ++n) *(f32x4*)(rowp + bj * HALF + n * 16) = acc[ai][bj][m][n]; }
    }
};
struct EpiMerge {
    static constexpr bool PERM = true;
    const bf16_t* G; int ldg; int gstride;
    bf16_t* O; int ldo;
    __device__ __forceinline__ bool keep(const Unit& u) const { return u.br < 2; }
    __device__ __forceinline__ void operator()(AccT& acc, const Unit& u, int wr, int wc, int fr, int fq) const {
        const int row0 = u.pm * BM + wr * 64 + fr, col0 = u.pn * BM + wc * 32 + 8 * fq;
#pragma unroll
        for (int ai = 0; ai < 2; ++ai)
#pragma unroll
            for (int m = 0; m < 4; ++m) { const size_t row = (size_t)(row0 + ai * HALF + m * 16);
#pragma unroll
                for (int bj = 0; bj < 2; ++bj) {
                    const bf16_t* gp = G + row * ldg + u.br * gstride + col0 + bj * HALF;
                    const u32x4 za = *(const u32x4*)gp;
                    float ea[8]; { const unsigned w[4] = {za.x, za.y, za.z, za.w};
#pragma unroll
                        for (int j = 0; j < 4; ++j) { ea[2 * j] = __expf(-bflo(w[j])); ea[2 * j + 1] = __expf(-bfhi(w[j])); } }
                    float f[8];
                    if (u.br < 2) { const u32x4 zb = *(const u32x4*)(gp + gstride); const unsigned w[4] = {zb.x, zb.y, zb.z, zb.w};
#pragma unroll
                        for (int j = 0; j < 4; ++j) { f[2 * j] = (1.f + __expf(-bflo(w[j]))) / (1.f + ea[2 * j]); f[2 * j + 1] = (1.f + __expf(-bfhi(w[j]))) / (1.f + ea[2 * j + 1]); } }
                    else {
#pragma unroll
                        for (int j = 0; j < 8; ++j) f[j] = 1.f / (1.f + ea[j]); }
                    f32x4 v0 = acc[ai][bj][m][0], v1 = acc[ai][bj][m][1];
                    v0 = v0 * (f32x4){f[0], f[1], f[2], f[3]}; v1 = v1 * (f32x4){f[4], f[5], f[6], f[7]};
                    if (u.br < 2) { acc[ai][bj][m][0] = v0; acc[ai][bj][m][1] = v1; }
                    else { u32x4 w; w.x = cvt_pk_bf16(v0[0], v0[1]); w.y = cvt_pk_bf16(v0[2], v0[3]); w.z = cvt_pk_bf16(v1[0], v1[1]); w.w = cvt_pk_bf16(v1[2], v1[3]);
                        *(u32x4*)(O + row * ldo + col0 + bj * HALF) = w; } } }
    }
};
struct EpiGateMul {
    static constexpr bool PERM = true;
    const bf16_t* E; int lde; float* T; int ldc;
    __device__ __forceinline__ bool keep(const Unit&) const { return false; }
    __device__ __forceinline__ void operator()(AccT& acc, const Unit& u, int wr, int wc, int fr, int fq) const {
        const int row0 = u.pm * BM + wr * 64 + fr, col0 = u.pn * BM + wc * 32 + 8 * fq;
#pragma unroll
        for (int ai = 0; ai < 2; ++ai)
#pragma unroll
            for (int m = 0; m < 4; ++m) { const size_t row = (size_t)(row0 + ai * HALF + m * 16);
#pragma unroll
                for (int bj = 0; bj < 2; ++bj) {
                    const u32x4 ev = *(const u32x4*)(E + row * lde + col0 + bj * HALF);
                    const f32x4 e0 = (f32x4){bflo(ev.x), bfhi(ev.x), bflo(ev.y), bfhi(ev.y)}, e1 = (f32x4){bflo(ev.z), bfhi(ev.z), bflo(ev.w), bfhi(ev.w)};
                    f32x4 v0 = acc[ai][bj][m][0], v1 = acc[ai][bj][m][1];
#pragma unroll
                    for (int j = 0; j < 4; ++j) { v0[j] = e0[j] / (1.f + __expf(-v0[j])); v1[j] = e1[j] / (1.f + __expf(-v1[j])); }
                    float* tp = T + row * ldc + col0 + bj * HALF;
                    *(f32x4*)tp = v0; *(f32x4*)(tp + 4) = v1; } }
    }
};

template <class Epi, bool ALIGN_EPI = true, bool SP2 = true>
__device__ __forceinline__ void gemm_phase(PG8_LAS unsigned char* lds, const Gemm g, const StaticOrder& S, const Epi& E) {
    int tid = threadIdx.x; asm volatile("" : "+v"(tid));
    const int wid = __builtin_amdgcn_readfirstlane(tid >> 6), lane = tid & 63, wr = wid >> 2, wc = wid & 3, fr = lane & 15, fq = lane >> 4;
    const int K = g.K, nt = K / BK;
    unsigned voffA[2], voffB[2];
#pragma unroll
    for (int i = 0; i < 2; ++i) { int R, C; stage_rc(tid * 16 + i * 8192, R, C); const int Rb = Epi::PERM ? ((R & ~31) + perm32(R & 31)) : R;
        voffA[i] = (unsigned)(R * K + C) * 2u; voffB[i] = (unsigned)(Rb * K + C) * 2u; }
    const size_t kstep = (size_t)(BK * 2);
    const size_t hstep = (size_t)HALF * K * 2;
    const size_t tstep = 2 * hstep;
    const unsigned ldsw = (unsigned)wid * 1024u;
    const int aoff = lds_byte(wr * 64 + fr, fq * 8), boff = lds_byte(wc * 32 + fr, fq * 8);
#define PG8_SA(b, h) (((b) * 2 + (h)) * HTB)
#define PG8_SB(b, h) ((4 + (b) * 2 + (h)) * HTB)
#define PG8_STAGE(bufoff, gbase, voff) do { _Pragma("unroll") for (int _i = 0; _i < 2; ++_i) \
        __builtin_amdgcn_global_load_lds((const unsigned*)((const char*)(gbase) + (voff)[_i]), (PG8_LAS unsigned*)(lds + (bufoff) + ldsw + _i * 8192), 16, 0, 0); } while (0)
#define PG8_LDA(dst, b, h) do { _Pragma("unroll") for (int m = 0; m < 4; ++m) _Pragma("unroll") for (int k = 0; k < 2; ++k) dst[m][k] = *(const PG8_LAS bf16x8*)(lds + PG8_SA(b, h) + aoff + m * 2048 + k * 1024); } while (0)
#define PG8_LDB(dst, b, h) do { _Pragma("unroll") for (int n = 0; n < 2; ++n) _Pragma("unroll") for (int k = 0; k < 2; ++k) dst[n][k] = *(const PG8_LAS bf16x8*)(lds + PG8_SB(b, h) + boff + n * 2048 + k * 1024); } while (0)
#define PG8_MMA(ai, bj, At, Bt) do { __builtin_amdgcn_s_setprio(1); _Pragma("unroll") for (int m = 0; m < 4; ++m) _Pragma("unroll") for (int n = 0; n < 2; ++n) _Pragma("unroll") for (int k = 0; k < 2; ++k) \
        acc[ai][bj][m][n] = __builtin_amdgcn_mfma_f32_16x16x32_bf16(Bt[n][k], At[m][k], acc[ai][bj][m][n], 0, 0, 0); __builtin_amdgcn_s_setprio(0); } while (0)
#define PG8_WAIT_V(n) asm volatile("s_waitcnt vmcnt(" #n ")" ::: "memory")
#define PG8_WAIT_L(n) asm volatile("s_waitcnt lgkmcnt(" #n ")" ::: "memory")
#define PG8_BAR __builtin_amdgcn_s_barrier()
#define PG8_SCHED __builtin_amdgcn_sched_barrier(0)
    Unit cur, nxt; int ui = 0;
    if (!S.next(0, cur)) return;
    AccT acc;
#pragma unroll
    for (int a = 0; a < 2; ++a)
#pragma unroll
        for (int b = 0; b < 2; ++b)
#pragma unroll
            for (int m = 0; m < 4; ++m)
#pragma unroll
                for (int n = 0; n < 2; ++n) acc[a][b][m][n] = (f32x4){0.f, 0.f, 0.f, 0.f};
    bf16x8 At[4][2], B0[2][2], B1[2][2];
    const char* cA = g.a(cur.br) + (size_t)cur.pm * tstep; const char* cB = g.b(cur.br) + (size_t)cur.pn * tstep;
    if constexpr (SP2) {
        PG8_STAGE(PG8_SB(0, 0), cB, voffB); PG8_STAGE(PG8_SB(0, 1), cB + hstep, voffB); PG8_STAGE(PG8_SA(0, 0), cA, voffA); PG8_STAGE(PG8_SA(0, 1), cA + hstep, voffA);
        if (wr == 1) PG8_BAR;
        PG8_WAIT_V(2); PG8_BAR;
        PG8_STAGE(PG8_SB(1, 0), cB + kstep, voffB); PG8_STAGE(PG8_SA(1, 0), cA + kstep, voffA); PG8_STAGE(PG8_SB(1, 1), cB + hstep + kstep, voffB);
        PG8_WAIT_V(6); PG8_BAR;
    } else {
        PG8_STAGE(PG8_SB(0, 0), cB, voffB); PG8_STAGE(PG8_SA(0, 0), cA, voffA); PG8_STAGE(PG8_SB(0, 1), cB + hstep, voffB); PG8_STAGE(PG8_SA(0, 1), cA + hstep, voffA);
        if (wr == 1) PG8_BAR;
        PG8_WAIT_V(4); PG8_BAR;
        PG8_STAGE(PG8_SB(1, 0), cB + kstep, voffB); PG8_STAGE(PG8_SA(1, 0), cA + kstep, voffA); PG8_STAGE(PG8_SB(1, 1), cB + hstep + kstep, voffB);
        PG8_WAIT_V(6); PG8_BAR;
    }
    for (;;) {
        const bool has_next = S.next(ui + 1, nxt);
        const char* nA = has_next ? g.a(nxt.br) + (size_t)nxt.pm * tstep : cA; const char* nB = has_next ? g.b(nxt.br) + (size_t)nxt.pn * tstep : cB;
        for (int t = 0; t < nt; t += 2) {
            const bool last = (t == nt - 2);
            const char* a1 = cA + (size_t)(t + 1) * kstep;
            const char* a2 = last ? nA : cA + (size_t)(t + 2) * kstep; const char* b2 = last ? nB : cB + (size_t)(t + 2) * kstep;
            const char* a3 = a2 + kstep; const char* b3 = b2 + kstep;
            if constexpr (SP2) {
            PG8_LDB(B0, 0, 0); PG8_LDB(B1, 0, 1); PG8_SCHED; PG8_LDA(At, 0, 0); PG8_STAGE(PG8_SA(1, 1), a1 + hstep, voffA);
            PG8_WAIT_V(8); PG8_WAIT_L(0); PG8_BAR; PG8_MMA(0, 0, At, B0); PG8_MMA(0, 1, At, B1); PG8_BAR; PG8_SCHED;
            PG8_LDA(At, 0, 1); PG8_STAGE(PG8_SB(0, 0), b2, voffB); PG8_STAGE(PG8_SB(0, 1), b2 + hstep, voffB); PG8_STAGE(PG8_SA(0, 0), a2, voffA);
            PG8_WAIT_V(8); PG8_WAIT_L(0); PG8_BAR; PG8_MMA(1, 0, At, B0); PG8_MMA(1, 1, At, B1); PG8_BAR; PG8_SCHED;
            PG8_LDB(B0, 1, 0); PG8_LDB(B1, 1, 1); PG8_SCHED; PG8_LDA(At, 1, 0); PG8_STAGE(PG8_SA(0, 1), a2 + hstep, voffA);
            PG8_WAIT_V(8); PG8_WAIT_L(0); PG8_BAR; PG8_MMA(0, 0, At, B0); PG8_MMA(0, 1, At, B1); PG8_BAR; PG8_SCHED;
            PG8_LDA(At, 1, 1); PG8_STAGE(PG8_SB(1, 0), b3, voffB); PG8_STAGE(PG8_SB(1, 1), b3 + hstep, voffB); PG8_STAGE(PG8_SA(1, 0), a3, voffA);
            PG8_WAIT_V(8); PG8_WAIT_L(0); PG8_BAR; PG8_MMA(1, 0, At, B0); PG8_MMA(1, 1, At, B1); PG8_BAR; PG8_SCHED;
            } else {
            PG8_LDB(B0, 0, 0); PG8_SCHED; PG8_LDA(At, 0, 0); PG8_STAGE(PG8_SA(1, 1), a1 + hstep, voffA);
            PG8_WAIT_L(8); PG8_BAR; PG8_WAIT_L(0); PG8_MMA(0, 0, At, B0); PG8_BAR; PG8_SCHED;
            PG8_LDB(B1, 0, 1); PG8_STAGE(PG8_SB(0, 0), b2, voffB);
            PG8_BAR; PG8_WAIT_L(0); PG8_MMA(0, 1, At, B1); PG8_BAR;
            PG8_LDA(At, 0, 1); PG8_STAGE(PG8_SA(0, 0), a2, voffA);
            PG8_BAR; PG8_WAIT_L(0); PG8_MMA(1, 0, At, B0); PG8_BAR; PG8_SCHED;
            PG8_STAGE(PG8_SB(0, 1), b2 + hstep, voffB);
            PG8_WAIT_V(6); PG8_BAR; PG8_MMA(1, 1, At, B1); PG8_BAR;
            PG8_LDB(B0, 1, 0); PG8_SCHED; PG8_LDA(At, 1, 0); PG8_STAGE(PG8_SA(0, 1), a2 + hstep, voffA);
            PG8_WAIT_L(8); PG8_BAR; PG8_WAIT_L(0); PG8_MMA(0, 0, At, B0); PG8_BAR; PG8_SCHED;
            PG8_LDB(B1, 1, 1); PG8_STAGE(PG8_SB(1, 0), b3, voffB);
            PG8_BAR; PG8_WAIT_L(0); PG8_MMA(0, 1, At, B1); PG8_BAR;
            PG8_LDA(At, 1, 1); PG8_STAGE(PG8_SA(1, 0), a3, voffA);
            PG8_BAR; PG8_WAIT_L(0); PG8_MMA(1, 0, At, B0); PG8_BAR; PG8_SCHED;
            PG8_STAGE(PG8_SB(1, 1), b3 + hstep, voffB);
            PG8_WAIT_V(6); PG8_BAR; PG8_MMA(1, 1, At, B1); PG8_BAR;
            }
        }
        if constexpr (ALIGN_EPI) { if (wr == 0) PG8_BAR; }
        E(acc, cur, wr, wc, fr, fq);
        if (!has_next) break;
        if (!E.keep(cur)) {
#pragma unroll
        for (int a = 0; a < 2; ++a)
#pragma unroll
            for (int b = 0; b < 2; ++b)
#pragma unroll
                for (int m = 0; m < 4; ++m)
#pragma unroll
                    for (int n = 0; n < 2; ++n) acc[a][b][m][n] = (f32x4){0.f, 0.f, 0.f, 0.f};
        }
        cur = nxt; cA = nA; cB = nB; ++ui;
        if constexpr (ALIGN_EPI) { if (wr == 1) PG8_BAR; }
    }
    PG8_WAIT_V(0);
    if constexpr (!ALIGN_EPI) { if (wr == 0) PG8_BAR; }
    PG8_BAR;
#undef PG8_SA
#undef PG8_SB
#undef PG8_STAGE
#undef PG8_LDA
#undef PG8_LDB
#undef PG8_MMA
#undef PG8_WAIT_V
#undef PG8_WAIT_L
#undef PG8_BAR
#undef PG8_SCHED
}
}

constexpr int NWAVES = 8;
constexpr int DM = 2048, NB = 4, SEQ = 4096, M = NB * SEQ, DEPTH = 4, PLE = 256;
constexpr int CCH = 1024, MH = 8, MHD = 128, MW = 1024, LCH = 64, NCH = SEQ / LCH;
constexpr int AQH = 16, AKVH = 4, AHD = 64, AQW = 1024, AKVW = 256, AWIN = 128;
constexpr int INW = 17936, ZW = 18176;
constexpr float EPS = 1e-6f;
constexpr int ZC_CB = 0, ZC_CC = 1024, ZC_CX = 2048, ZC_CG = 3072, ZC_MQ = 4096, ZC_MK = 5120, ZC_MV = 6144, ZC_MO = 7168, ZC_MG = 8192,
              ZC_AQ = 9216, ZC_AK = 10240, ZC_AV = 10496, ZC_AG = 10752, ZC_GT = 11776, ZC_MI = 17920, ZC_MF = 17928;
__host__ __device__ __forceinline__ int zsrc(int n) { return n < 8192 ? n : (n < 17920 ? n + 16 : (n < INW ? n - 17920 + 8192 : -1)); }

constexpr size_t MiB = 1u << 20;
constexpr size_t WS_CTL = 0, CTL_ZERO_BYTES = 1 * MiB;
constexpr size_t WS_ROPE = 1 * MiB;
constexpr size_t WS_PB = 5 * MiB;
constexpr size_t WS_WIN = 37 * MiB;
constexpr size_t WS_WUP = 321 * MiB;
constexpr size_t WS_WOUT = 369 * MiB;
constexpr size_t WS_WG = 401 * MiB;
constexpr size_t WS_WPLE = 433 * MiB;
constexpr size_t WS_XB = 437 * MiB;
constexpr size_t WS_Z = 501 * MiB;
constexpr size_t WS_YC = 1069 * MiB, WS_YM = 1101 * MiB, WS_YA = 1133 * MiB;
constexpr size_t WS_MRG = 1165 * MiB;
constexpr size_t WS_YT = 1229 * MiB;
constexpr size_t WS_E = 1357 * MiB;
constexpr size_t WS_CST = 1421 * MiB;
constexpr size_t WS_NST = 1549 * MiB;
constexpr size_t WS_SCL = 1550 * MiB;
constexpr size_t WS_END = 1551 * MiB;
constexpr int CW_TMO = 0, CW_BAR = 4096;

constexpr int RING_OFF = 0, RING_BYTES = 131072;
constexpr int SCAL_OFF = RING_BYTES;
constexpr int MISC_OFF = SCAL_OFF + 8192;
constexpr int LDS_BYTES = 147456;

#define GAS __attribute__((address_space(1)))
#define LAS __attribute__((address_space(3)))
typedef unsigned short bf16;
typedef unsigned v4u __attribute__((ext_vector_type(4)));
typedef unsigned v2u __attribute__((ext_vector_type(2)));
typedef float f32x4 __attribute__((ext_vector_type(4)));
typedef float f32x16 __attribute__((ext_vector_type(16)));
typedef short bf16x8 __attribute__((ext_vector_type(8)));
typedef GAS unsigned gu32;
#define RLX_AGENT __ATOMIC_RELAXED, __HIP_MEMORY_SCOPE_AGENT
#define LDS_WAIT() asm volatile("s_waitcnt lgkmcnt(0)" ::: "memory")
#define VM_WAIT() asm volatile("s_waitcnt vmcnt(0)" ::: "memory")
__device__ __forceinline__ unsigned f2bf(float f) { unsigned u = __builtin_bit_cast(unsigned, f); return (u + 0x7fffu + ((u >> 16) & 1u)) >> 16; }
__device__ __forceinline__ unsigned pk2(float lo, float hi) { return f2bf(lo) | (f2bf(hi) << 16); }
__device__ __forceinline__ float bf2f(unsigned short b) { return __uint_as_float(((unsigned)b) << 16); }
__device__ __forceinline__ float bflo(unsigned w) { return __uint_as_float(w << 16); }
__device__ __forceinline__ float bfhi(unsigned w) { return __uint_as_float(w & 0xffff0000u); }
__device__ __forceinline__ void unpack8(const v4u w, float* f) { f[0] = bflo(w.x); f[1] = bfhi(w.x); f[2] = bflo(w.y); f[3] = bfhi(w.y); f[4] = bflo(w.z); f[5] = bfhi(w.z); f[6] = bflo(w.w); f[7] = bfhi(w.w); }
__device__ __forceinline__ v4u pack8(const float* f) { v4u w; w.x = pk2(f[0], f[1]); w.y = pk2(f[2], f[3]); w.z = pk2(f[4], f[5]); w.w = pk2(f[6], f[7]); return w; }
__device__ __forceinline__ float sigmoidf_(float x) { return 1.f / (1.f + __expf(-x)); }
__device__ __forceinline__ float siluf_(float x) { return x / (1.f + __expf(-x)); }

#define XB_TMO      128
#define XB_XCNT(j)  (256  + 64 * (j))
#define XB_XSUB(j)  (1280 + 64 * (j))
#define XB_XGEN(j)  (2304 + 64 * (j))
#define XB_TOP      3328
#define XB_TOPGEN   3392
#define XCD_BAR_WORDS 3456
#define XB_SPIN_CAP (1u << 18)
__device__ __forceinline__ unsigned xb_ld(unsigned* p)              { return __hip_atomic_load(p, __ATOMIC_RELAXED, __HIP_MEMORY_SCOPE_AGENT); }
__device__ __forceinline__ unsigned xb_add(unsigned* p, unsigned v) { return __hip_atomic_fetch_add(p, v, __ATOMIC_RELAXED, __HIP_MEMORY_SCOPE_AGENT); }
__device__ __forceinline__ unsigned xb_xcc_id() { return (unsigned)__builtin_amdgcn_s_getreg((3 << 11) | 20) & 0xFu; }
#define XB_SPIN(cond, bar) do { unsigned _sp = 0; while (cond) { __builtin_amdgcn_s_sleep(1); \
    if ((++_sp & 255u) == 0u) { if (xb_ld(&(bar)[XB_TMO])) break; if (_sp > XB_SPIN_CAP) { atomicAdd(&(bar)[XB_TMO], 1u); break; } } } } while (0)
struct XcdBarrier { unsigned* bar; unsigned x; volatile LAS unsigned* st; };
__device__ __forceinline__ XcdBarrier xcd_barrier_post(unsigned* bar, volatile LAS unsigned* st) {
    XcdBarrier b; b.bar = bar; b.x = xb_xcc_id(); b.st = st;
    if (threadIdx.x == 0) (void)xb_add(&bar[XB_XCNT(b.x)], 1u);
    return b;
}
__device__ __forceinline__ void xcd_barrier_complete(unsigned* bar, unsigned x, unsigned& nloc, unsigned& nx) {
    const unsigned G = gridDim.x * gridDim.y * gridDim.z;
    unsigned sum, cnt, mine, sp = 0u;
    for (;;) {
        sum = 0u; cnt = 0u; mine = 0u;
#pragma unroll
        for (unsigned j = 0; j < 16; ++j) { const unsigned c = xb_ld(&bar[XB_XCNT(j)]); sum += c; cnt += (c > 0u) ? 1u : 0u; mine = (j == x) ? c : mine; }
        if (sum == G) break;
        __builtin_amdgcn_s_sleep(1);
        if ((++sp & 255u) == 0u) { if (xb_ld(&bar[XB_TMO])) break; if (sp > XB_SPIN_CAP) { atomicAdd(&bar[XB_TMO], 1u); break; } }
    }
    nloc = mine > 0u ? mine : 1u; nx = cnt > 0u ? cnt : 1u;
}
__device__ __forceinline__ void xcd_barrier(const XcdBarrier& b) {
    asm volatile("s_waitcnt vmcnt(0)" ::: "memory");
    __syncthreads();
    if (threadIdx.x == 0) {
        unsigned* bar = b.bar;
        __builtin_amdgcn_s_waitcnt(0);
        unsigned nloc = b.st[0], nx = b.st[1];
        if (nloc == 0u) { xcd_barrier_complete(bar, b.x, nloc, nx); b.st[0] = nloc; b.st[1] = nx; }
        const unsigned old = xb_add(&bar[XB_XSUB(b.x)], 1u);
        const unsigned gen = old / nloc;
        if (old + 1u == (gen + 1u) * nloc) {
            __builtin_amdgcn_fence(__ATOMIC_RELEASE, "agent");
            asm volatile("s_waitcnt vmcnt(0)" ::: "memory");
            const unsigned og = xb_add(&bar[XB_TOP], 1u);
            const unsigned tg = og / nx;
            if (og + 1u == (tg + 1u) * nx) xb_add(&bar[XB_TOPGEN], 1u);
            else XB_SPIN(xb_ld(&bar[XB_TOPGEN]) == tg, bar);
            __builtin_amdgcn_fence(__ATOMIC_ACQUIRE, "agent");
            xb_add(&bar[XB_XGEN(b.x)], 1u);
            asm volatile("s_waitcnt vmcnt(0)" ::: "memory");
        } else {
            XB_SPIN(xb_ld(&bar[XB_XGEN(b.x)]) == gen, bar);
            __builtin_amdgcn_fence(__ATOMIC_ACQUIRE, "agent");
            asm volatile("s_waitcnt vmcnt(0)" ::: "memory");
        }
    }
    __syncthreads();
}

struct Frame {
    LAS unsigned char* lds;
    int tid, lane, wave;
    int vcu, G;
    unsigned char* ws;
    float* out;
    const float* x; const float* p; const int* pos; const float* w_in; const float* conv_w; const float* b_ig; const float* b_fg; const float* m_norm; const float* sinks;
    const float *w_up0, *w_up1, *w_up2; const float* w_out; const float* pre_g; const float* post_g; const float* w_ple; const float* w_pg; const float* ple_g;
};
__device__ __forceinline__ void relaunder(Frame& F) { int t = threadIdx.x; asm volatile("" : "+v"(t)); F.tid = t; F.lane = t & 63; F.wave = __builtin_amdgcn_readfirstlane(t >> 6); }
__device__ __forceinline__ float wave_sum(float v) {
#pragma unroll
    for (int o = 1; o < 64; o <<= 1) v += __shfl_xor(v, o);
    return v;
}
__device__ __forceinline__ float wave_max(float v) {
#pragma unroll
    for (int o = 1; o < 64; o <<= 1) v = fmaxf(v, __shfl_xor(v, o));
    return v;
}

template <bool ZMAP>
__device__ __forceinline__ void p0_transpose_item(const float* W, int K, int Nsrc, int Ndst, bf16* WT, LAS float* scr, int item, int lane) {
    const int nblk = Ndst / 32, kb = item / nblk, nb = item % nblk, k0 = 64 * kb, n0 = 32 * nb;
    const int nd = n0 + (lane & 31); const int ns = ZMAP ? zsrc(nd) : nd;
#pragma unroll 8
    for (int i = 0; i < 32; ++i) { const int kk = 2 * i + (lane >> 5); scr[kk * 33 + (lane & 31)] = ns >= 0 ? W[(size_t)(k0 + kk) * Nsrc + ns] : 0.f; }
    LDS_WAIT(); asm volatile("" ::: "memory");
    const int c = lane & 7;
#pragma unroll
    for (int j = 0; j < 4; ++j) { const int n = (lane >> 3) + 8 * j; const LAS float* s = scr + (8 * c) * 33 + n;
        v4u o; o.x = pk2(s[0 * 33], s[1 * 33]); o.y = pk2(s[2 * 33], s[3 * 33]); o.z = pk2(s[4 * 33], s[5 * 33]); o.w = pk2(s[6 * 33], s[7 * 33]);
        *(GAS v4u*)(WT + (size_t)(n0 + n) * K + k0 + 8 * c) = o; }
    LDS_WAIT(); asm volatile("" ::: "memory");
}
__device__ __forceinline__ void sincos_red(double a, float& s, float& c) {
    const double k = __builtin_rint(a * 0.63661977236758134308);
    double r = __builtin_fma(-k, 1.57079632679489655800e+00, a); r = __builtin_fma(-k, 6.12323399573676603587e-17, r);
    const int q = ((int)k) & 3; const float x = (float)r, x2 = x * x;
    const float sp = x + x * x2 * (-1.6666654611e-1f + x2 * (8.3321608736e-3f + x2 * (-1.9515295891e-4f)));
    const float cp = 1.f - 0.5f * x2 + x2 * x2 * (4.166664568298827e-2f + x2 * (-1.388731625493765e-3f + x2 * 2.443315711809948e-5f));
    s = (q == 0) ? sp : (q == 1) ? cp : (q == 2) ? -sp : -cp;
    c = (q == 0) ? cp : (q == 1) ? -sp : (q == 2) ? -cp : sp;
}
__device__ __forceinline__ void rms_store_bf16(const f32x4 (&v)[8], const float* g, bf16* orow, int lane) {
    float ss = 0.f;
#pragma unroll
    for (int j = 0; j < 8; ++j) ss += (v[j].x * v[j].x + v[j].y * v[j].y) + (v[j].z * v[j].z + v[j].w * v[j].w);
    const float r = 1.f / sqrtf(wave_sum(ss) * (1.f / DM) + EPS);
#pragma unroll
    for (int j = 0; j < 8; ++j) { const f32x4 gg = *(const GAS f32x4*)(g + 4 * (lane + 64 * j));
        v2u o; o.x = pk2(v[j].x * r * gg.x, v[j].y * r * gg.y); o.y = pk2(v[j].z * r * gg.z, v[j].w * r * gg.w);
        *(GAS v2u*)(orow + 4 * (lane + 64 * j)) = o; }
}

__device__ __forceinline__ void p0_prologue(Frame& F) {
    relaunder(F);
    LAS float* scr = (LAS float*)(F.lds + RING_OFF + F.wave * 16384);
    const int gw = F.vcu * NWAVES + F.wave, NGW = F.G * NWAVES;
    constexpr int I_IN = (DM / 64) * (ZW / 32), I_UP = (1024 / 64) * (DM / 32), I_SQ = (DM / 64) * (DM / 32), I_PLE = (PLE / 64) * (DM / 32);
    constexpr int PER_LAYER = I_IN + 3 * I_UP + 2 * I_SQ + I_PLE;
    for (int it = gw; it < DEPTH * PER_LAYER; it += NGW) {
        const int l = it / PER_LAYER; int r = it - l * PER_LAYER;
        if (r < I_IN) { p0_transpose_item<true>(F.w_in + (size_t)l * DM * INW, DM, INW, ZW, (bf16*)(F.ws + WS_WIN) + (size_t)l * ZW * DM, scr, r, F.lane); continue; } r -= I_IN;
        if (r < I_UP) { p0_transpose_item<false>(F.w_up0 + (size_t)l * 1024 * DM, 1024, DM, DM, (bf16*)(F.ws + WS_WUP) + (size_t)(l * 3 + 0) * DM * 1024, scr, r, F.lane); continue; } r -= I_UP;
        if (r < I_UP) { p0_transpose_item<false>(F.w_up1 + (size_t)l * 1024 * DM, 1024, DM, DM, (bf16*)(F.ws + WS_WUP) + (size_t)(l * 3 + 1) * DM * 1024, scr, r, F.lane); continue; } r -= I_UP;
        if (r < I_UP) { p0_transpose_item<false>(F.w_up2 + (size_t)l * 1024 * DM, 1024, DM, DM, (bf16*)(F.ws + WS_WUP) + (size_t)(l * 3 + 2) * DM * 1024, scr, r, F.lane); continue; } r -= I_UP;
        if (r < I_SQ) { p0_transpose_item<false>(F.w_out + (size_t)l * DM * DM, DM, DM, DM, (bf16*)(F.ws + WS_WOUT) + (size_t)l * DM * DM, scr, r, F.lane); continue; } r -= I_SQ;
        if (r < I_SQ) { p0_transpose_item<false>(F.w_pg + (size_t)l * DM * DM, DM, DM, DM, (bf16*)(F.ws + WS_WG) + (size_t)l * DM * DM, scr, r, F.lane); continue; } r -= I_SQ;
        p0_transpose_item<false>(F.w_ple + (size_t)l * PLE * DM, PLE, DM, DM, (bf16*)(F.ws + WS_WPLE) + (size_t)l * DM * PLE, scr, r, F.lane);
    }
    { const size_t n8 = (size_t)DEPTH * M * PLE / 8; bf16* pb = (bf16*)(F.ws + WS_PB);
      for (size_t i = (size_t)F.vcu * 512 + F.tid; i < n8; i += (size_t)F.G * 512) { const f32x4 a = *(const GAS f32x4*)(F.p + 8 * i), b = *(const GAS f32x4*)(F.p + 8 * i + 4);
          v4u o; o.x = pk2(a.x, a.y); o.y = pk2(a.z, a.w); o.z = pk2(b.x, b.y); o.w = pk2(b.z, b.w); *(GAS v4u*)(pb + 8 * i) = o; } }
    { float* rt = (float*)(F.ws + WS_ROPE);
      for (int i = F.vcu * 512 + F.tid; i < M * 32; i += F.G * 512) { const int m = i >> 5, f = i & 31;
          const double inv = exp(-(double)f * (9.210340371976184 / 32.0));
          float s, c; sincos_red((double)F.pos[m] * inv, s, c); rt[2 * i] = c; rt[2 * i + 1] = s; } }
    for (int m = gw; m < M; m += NGW) { f32x4 v[8];
#pragma unroll
        for (int j = 0; j < 8; ++j) v[j] = *(const GAS f32x4*)(F.x + (size_t)m * DM + 4 * (F.lane + 64 * j));
        rms_store_bf16(v, F.pre_g, (bf16*)(F.ws + WS_XB) + (size_t)m * DM, F.lane); }
}

__device__ __forceinline__ void phase_norm1(Frame& F, int l) {
    relaunder(F);
    const int gw = F.vcu * NWAVES + F.wave, NGW = F.G * NWAVES;
    const float* xin = (l == 0) ? F.x : F.out; const float* Y = (const float*)(F.ws + WS_YT); const float* g = F.post_g + l * DM; bf16* XB = (bf16*)(F.ws + WS_XB);
    for (int m = gw; m < M; m += NGW) { f32x4 y[8]; float ss = 0.f;
#pragma unroll
        for (int j = 0; j < 8; ++j) { y[j] = *(const GAS f32x4*)(Y + (size_t)m * DM + 4 * (F.lane + 64 * j)); ss += (y[j].x * y[j].x + y[j].y * y[j].y) + (y[j].z * y[j].z + y[j].w * y[j].w); }
        const float r = 1.f / sqrtf(wave_sum(ss) * (1.f / DM) + EPS);
#pragma unroll
        for (int j = 0; j < 8; ++j) { const int c = 4 * (F.lane + 64 * j); const f32x4 gg = *(const GAS f32x4*)(g + c); const f32x4 xv = *(const GAS f32x4*)(xin + (size_t)m * DM + c);
            const f32x4 o = xv + y[j] * r * gg; *(GAS f32x4*)(F.out + (size_t)m * DM + c) = o;
            v2u w; w.x = pk2(o.x, o.y); w.y = pk2(o.z, o.w); *(GAS v2u*)(XB + (size_t)m * DM + c) = w; } }
}
__device__ __forceinline__ void phase_norm2(Frame& F, int l) {
    relaunder(F);
    const int gw = F.vcu * NWAVES + F.wave, NGW = F.G * NWAVES;
    const float* T = (const float*)(F.ws + WS_YT); const float* g = F.ple_g + l * DM; bf16* XB = (bf16*)(F.ws + WS_XB);
    for (int m = gw; m < M; m += NGW) { f32x4 y[8]; float ss = 0.f;
#pragma unroll
        for (int j = 0; j < 8; ++j) { y[j] = *(const GAS f32x4*)(T + (size_t)m * DM + 4 * (F.lane + 64 * j)); ss += (y[j].x * y[j].x + y[j].y * y[j].y) + (y[j].z * y[j].z + y[j].w * y[j].w); }
        const float r = 1.f / sqrtf(wave_sum(ss) * (1.f / DM) + EPS);
#pragma unroll
        for (int j = 0; j < 8; ++j) { const int c = 4 * (F.lane + 64 * j); const f32x4 gg = *(const GAS f32x4*)(g + c); const f32x4 xv = *(const GAS f32x4*)(F.out + (size_t)m * DM + c);
            y[j] = xv + y[j] * r * gg; *(GAS f32x4*)(F.out + (size_t)m * DM + c) = y[j]; }
        if (l < DEPTH - 1) rms_store_bf16(y, F.pre_g + (l + 1) * DM, XB + (size_t)m * DM, F.lane); }
}

__device__ __forceinline__ void phase_conv(Frame& F, int l) {
    relaunder(F);
    const bf16* Z = (const bf16*)(F.ws + WS_Z); bf16* YC = (bf16*)(F.ws + WS_YC);
    const int cg = F.tid & 127, ts = F.tid >> 7, c0 = cg * 8;
    float w0[8], w1[8], w2[8];
#pragma unroll
    for (int j = 0; j < 8; ++j) { w0[j] = F.conv_w[(l * 3 + 0) * CCH + c0 + j]; w1[j] = F.conv_w[(l * 3 + 1) * CCH + c0 + j]; w2[j] = F.conv_w[(l * 3 + 2) * CCH + c0 + j]; }
    for (int u = F.vcu; u < M / 64; u += F.G) {
        const int t0 = u * 64 + ts * 16;
        float vm2[8], vm1[8];
        if ((t0 & (SEQ - 1)) == 0) {
#pragma unroll
            for (int j = 0; j < 8; ++j) { vm2[j] = 0.f; vm1[j] = 0.f; }
        } else { float a[8], b[8];
            unpack8(*(const GAS v4u*)(Z + (size_t)(t0 - 2) * ZW + ZC_CC + c0), a); unpack8(*(const GAS v4u*)(Z + (size_t)(t0 - 2) * ZW + ZC_CX + c0), b);
#pragma unroll
            for (int j = 0; j < 8; ++j) vm2[j] = a[j] * b[j];
            unpack8(*(const GAS v4u*)(Z + (size_t)(t0 - 1) * ZW + ZC_CC + c0), a); unpack8(*(const GAS v4u*)(Z + (size_t)(t0 - 1) * ZW + ZC_CX + c0), b);
#pragma unroll
            for (int j = 0; j < 8; ++j) vm1[j] = a[j] * b[j]; }
#pragma unroll 4
        for (int i = 0; i < 16; ++i) { const size_t zr = (size_t)(t0 + i) * ZW; float a[8], b[8], cb[8], gg[8], o[8];
            unpack8(*(const GAS v4u*)(Z + zr + ZC_CC + c0), a); unpack8(*(const GAS v4u*)(Z + zr + ZC_CX + c0), b);
            unpack8(*(const GAS v4u*)(Z + zr + ZC_CB + c0), cb); unpack8(*(const GAS v4u*)(Z + zr + ZC_CG + c0), gg);
#pragma unroll
            for (int j = 0; j < 8; ++j) { const float v = a[j] * b[j]; const float y = w0[j] * vm2[j] + w1[j] * vm1[j] + w2[j] * v; o[j] = cb[j] * y * siluf_(gg[j]); vm2[j] = vm1[j]; vm1[j] = v; }
            *(GAS v4u*)(YC + (size_t)(t0 + i) * CCH + c0) = pack8(o); }
    }
}

__device__ __forceinline__ void phase_attn_naive(Frame& F, int l) {
    relaunder(F);
    const bf16* Z = (const bf16*)(F.ws + WS_Z); bf16* YA = (bf16*)(F.ws + WS_YA); const float* rope = (const float*)(F.ws + WS_ROPE);
    const int gw = F.vcu * NWAVES + F.wave, NGW = F.G * NWAVES, d = F.lane, f = d & 31;
    for (int task = gw; task < M * AQH; task += NGW) {
        const int m = task >> 4, hq = task & 15, kvh = hq >> 2, s = m & (SEQ - 1);
        float q = bf2f(Z[(size_t)m * ZW + ZC_AQ + hq * 64 + d]); { const float pq = __shfl_xor(q, 32); const float c = rope[2 * (m * 32 + f)], sn = rope[2 * (m * 32 + f) + 1];
            q = (d < 32 ? q * c - pq * sn : q * c + pq * sn) * 0.125f; }
        float sc0 = -INFINITY, sc1 = -INFINITY;
        for (int kidx = 0; kidx < AWIN; ++kidx) { if (s - 127 + kidx < 0) continue; const int mk = m - 127 + kidx;
            float k = bf2f(Z[(size_t)mk * ZW + ZC_AK + kvh * 64 + d]); const float pk = __shfl_xor(k, 32); const float c = rope[2 * (mk * 32 + f)], sn = rope[2 * (mk * 32 + f) + 1];
            k = d < 32 ? k * c - pk * sn : k * c + pk * sn;
            const float sc = wave_sum(q * k);
            if (d == (kidx & 63)) { if (kidx < 64) sc0 = sc; else sc1 = sc; } }
        const float sink = F.sinks[l * AQH + hq];
        const float mx = fmaxf(wave_max(fmaxf(sc0, sc1)), sink);
        const float p0 = __expf(sc0 - mx), p1 = __expf(sc1 - mx);
        const float den = wave_sum(p0 + p1) + __expf(sink - mx);
        float o = 0.f;
        for (int kidx = 0; kidx < AWIN; ++kidx) { if (s - 127 + kidx < 0) continue; const int mk = m - 127 + kidx;
            const float pp = __shfl(kidx < 64 ? p0 : p1, kidx & 63);
            o += pp * bf2f(Z[(size_t)mk * ZW + ZC_AV + kvh * 64 + d]); }
        o = o / den * siluf_(bf2f(Z[(size_t)m * ZW + ZC_AG + hq * 64 + d]));
        YA[(size_t)m * AQW + hq * 64 + d] = (bf16)f2bf(o);
    }
}

constexpr int RS128 = 272, RS64 = 144, RSH = 528;
constexpr int L_Q = 0, L_K = 17408, L_V = 34816, L_CP = 52224, L_SW = 87040, L_HB = 96256;
constexpr int S_W = 0, S_ROWT = 256, S_COLT = 512, S_WQ = 768, S_EM = 1024, S_DEN = 1280, S_NP = 1536;
__device__ __forceinline__ float logsigmoidf_(float x) { return x >= 0.f ? -log1pf(expf(-x)) : x - log1pf(expf(x)); }

__device__ __forceinline__ void chunk_gates(Frame& F, int l, const bf16* Z, int m0, int h, float& bc, float& li) {
    const float fpre = bf2f(Z[(size_t)(m0 + F.lane) * ZW + ZC_MF + h]) + F.b_fg[l * MH + h];
    li = bf2f(Z[(size_t)(m0 + F.lane) * ZW + ZC_MI + h]) + F.b_ig[l * MH + h];
    bc = logsigmoidf_(fpre);
#pragma unroll
    for (int o = 1; o < 64; o <<= 1) { const float t = __shfl_up(bc, o); if (F.lane >= o) bc += t; }
}

__device__ __forceinline__ void phase_m1(Frame& F, int l) {
    relaunder(F);
    const bf16* Z = (const bf16*)(F.ws + WS_Z); float* CST = (float*)(F.ws + WS_CST); float* NST = (float*)(F.ws + WS_NST); float* SCL = (float*)(F.ws + WS_SCL);
    LAS unsigned char* ring = F.lds + RING_OFF; LAS float* sw = (LAS float*)(F.lds + SCAL_OFF + S_W);
    for (int u = F.vcu; u < NB * MH * NCH; u += F.G) {
        const int bh = u >> 6, c = u & 63, b = bh >> 3, h = bh & 7, m0 = b * SEQ + c * LCH;
        if (F.wave == 0) { float bc, li; chunk_gates(F, l, Z, m0, h, bc, li);
            const float blast = __shfl(bc, 63); const float g = blast - bc + li; const float gmax = wave_max(g);
            sw[F.lane] = __expf(g - gmax);
            if (F.lane == 0) { SCL[u] = gmax; SCL[2048 + u] = blast; } }
        __syncthreads();
#pragma unroll
        for (int i = 0; i < 2; ++i) { const int ch = F.tid + 512 * i, r = ch >> 4, cc = ch & 15; const size_t zr = (size_t)(m0 + r) * ZW + h * MHD + cc * 8;
            float v[8]; unpack8(*(const GAS v4u*)(Z + zr + ZC_MV), v); const float w = sw[r];
#pragma unroll
            for (int j = 0; j < 8; ++j) v[j] *= w;
            *(LAS v4u*)(ring + L_Q + r * RS128 + cc * 16) = pack8(v);
            *(LAS v4u*)(ring + L_K + r * RS128 + cc * 16) = *(const GAS v4u*)(Z + zr + ZC_MK); }
        __syncthreads();
        if (F.tid < 128) { float n = 0.f;
            for (int r = 0; r < 64; ++r) n += sw[r] * bf2f(*(LAS bf16*)(ring + L_K + r * RS128 + F.tid * 2));
            NST[(size_t)u * 128 + F.tid] = n; }
        {
            const int d = F.tid >> 2, e0 = (F.tid & 3) * 32; float acc[32];
#pragma unroll
            for (int j = 0; j < 32; ++j) acc[j] = 0.f;
            for (int r = 0; r < 64; ++r) { const float vw = bf2f(*(LAS bf16*)(ring + L_Q + r * RS128 + d * 2));
#pragma unroll
                for (int q = 0; q < 4; ++q) { float kk[8]; unpack8(*(LAS v4u*)(ring + L_K + r * RS128 + (e0 + 8 * q) * 2), kk);
#pragma unroll
                    for (int j = 0; j < 8; ++j) acc[8 * q + j] += vw * kk[j]; } }
            float* cp = CST + (size_t)u * 16384 + d * 128 + e0;
#pragma unroll
            for (int q = 0; q < 8; ++q) *(GAS f32x4*)(cp + 4 * q) = (f32x4){acc[4 * q], acc[4 * q + 1], acc[4 * q + 2], acc[4 * q + 3]}; }
        __syncthreads();
    }
}
__device__ __forceinline__ void phase_m2(Frame& F) {
    relaunder(F);
    float* CST = (float*)(F.ws + WS_CST); float* NST = (float*)(F.ws + WS_NST); float* SCL = (float*)(F.ws + WS_SCL);
    for (int gid = F.vcu * 512 + F.tid; gid < 32 * 4096 + 32 * 32; gid += F.G * 512) {
        const bool isn = gid >= 32 * 4096; const int g2 = isn ? gid - 32 * 4096 : gid;
        const int bh = isn ? (g2 >> 5) : (g2 >> 12), idx = isn ? (g2 & 31) : (g2 & 4095);
        float* base = isn ? NST + (size_t)bh * 64 * 128 + idx * 4 : CST + (size_t)bh * 64 * 16384 + idx * 4; const size_t cs = isn ? 128 : 16384;
        float mrun = 0.f; f32x4 st = (f32x4){0.f, 0.f, 0.f, 0.f};
        for (int c0 = 0; c0 < 64; c0 += 8) { f32x4 tmp[8];
#pragma unroll
            for (int j = 0; j < 8; ++j) tmp[j] = *(const GAS f32x4*)(base + (size_t)(c0 + j) * cs);
#pragma unroll
            for (int j = 0; j < 8; ++j) { const float gm = SCL[bh * 64 + c0 + j], bl = SCL[2048 + bh * 64 + c0 + j];
                const float mnew = fmaxf(bl + mrun, gm), a = __expf(bl + mrun - mnew), cc = __expf(gm - mnew);
                *(GAS f32x4*)(base + (size_t)(c0 + j) * cs) = st;
                if (!isn && idx == 0) SCL[4096 + bh * 64 + c0 + j] = mrun;
                st = st * a + tmp[j] * cc; mrun = mnew; } }
    }
}
__device__ __forceinline__ void phase_m3(Frame& F, int l) {
    relaunder(F);
    const bf16* Z = (const bf16*)(F.ws + WS_Z); const float* CST = (const float*)(F.ws + WS_CST); const float* NST = (const float*)(F.ws + WS_NST); const float* SCL = (const float*)(F.ws + WS_SCL);
    bf16* YM = (bf16*)(F.ws + WS_YM);
    LAS unsigned char* ring = F.lds + RING_OFF; LAS unsigned char* scal = F.lds + SCAL_OFF;
    LAS float* s_rowt = (LAS float*)(scal + S_ROWT); LAS float* s_colt = (LAS float*)(scal + S_COLT); LAS float* s_wq = (LAS float*)(scal + S_WQ);
    LAS float* s_em = (LAS float*)(scal + S_EM); LAS float* s_den = (LAS float*)(scal + S_DEN); LAS float* s_np = (LAS float*)(scal + S_NP);
    const float scale = 0.08838834764831845f;
    for (int u = F.vcu; u < NB * MH * NCH; u += F.G) {
        const int bh = u >> 6, c = u & 63, b = bh >> 3, h = bh & 7, m0 = b * SEQ + c * LCH;
        if (F.wave == 0) { float bc, li; chunk_gates(F, l, Z, m0, h, bc, li);
            const float uu = li - bc; float pm = uu;
#pragma unroll
            for (int o = 1; o < 64; o <<= 1) { const float t = __shfl_up(pm, o); if (F.lane >= o) pm = fmaxf(pm, t); }
            const float mp = SCL[4096 + u], inter = bc + mp, mm = fmaxf(inter, bc + pm);
            s_rowt[F.lane] = bc - mm; s_colt[F.lane] = uu; s_wq[F.lane] = __expf(inter - mm) * scale; s_em[F.lane] = __expf(-mm); }
        if (F.wave == 1) { s_np[F.lane] = NST[(size_t)u * 128 + F.lane]; s_np[64 + F.lane] = NST[(size_t)u * 128 + 64 + F.lane]; }
#pragma unroll
        for (int i = 0; i < 2; ++i) { const int ch = F.tid + 512 * i, r = ch >> 4, cc = ch & 15; const size_t zr = (size_t)(m0 + r) * ZW + h * MHD + cc * 8;
            *(LAS v4u*)(ring + L_Q + r * RS128 + cc * 16) = *(const GAS v4u*)(Z + zr + ZC_MQ);
            *(LAS v4u*)(ring + L_K + r * RS128 + cc * 16) = *(const GAS v4u*)(Z + zr + ZC_MK);
            *(LAS v4u*)(ring + L_V + r * RS128 + cc * 16) = *(const GAS v4u*)(Z + zr + ZC_MV); }
#pragma unroll
        for (int i = 0; i < 4; ++i) { const int ch = F.tid + 512 * i, r = ch >> 4, cc = ch & 15; const float* cp = CST + (size_t)u * 16384 + r * 128 + cc * 8;
            const f32x4 a = *(const GAS f32x4*)cp, bq = *(const GAS f32x4*)(cp + 4);
            v4u o; o.x = pk2(a.x, a.y); o.y = pk2(a.z, a.w); o.z = pk2(bq.x, bq.y); o.w = pk2(bq.z, bq.w);
            *(LAS v4u*)(ring + L_CP + r * RS128 + cc * 16) = o; }
        __syncthreads();
        {
            const int li = F.tid >> 3, s0 = (F.tid & 7) * 8; float sv[8];
#pragma unroll
            for (int j = 0; j < 8; ++j) sv[j] = 0.f;
            if (s0 <= li) {
                for (int cc = 0; cc < 16; ++cc) { float qv[8]; unpack8(*(LAS v4u*)(ring + L_Q + li * RS128 + cc * 16), qv);
#pragma unroll
                    for (int j = 0; j < 8; ++j) { float kv[8]; unpack8(*(LAS v4u*)(ring + L_K + (s0 + j) * RS128 + cc * 16), kv);
#pragma unroll
                        for (int e = 0; e < 8; ++e) sv[j] += qv[e] * kv[e]; } }
                const float rt = s_rowt[li];
#pragma unroll
                for (int j = 0; j < 8; ++j) sv[j] = (s0 + j <= li) ? sv[j] * scale * __expf(rt + s_colt[s0 + j]) : 0.f; }
            *(LAS v4u*)(ring + L_SW + li * RS64 + s0 * 2) = pack8(sv); }
        __syncthreads();
        {
            const int li = F.tid >> 3, sub = F.tid & 7, d0 = sub * 16; float a1[16], a2[16];
#pragma unroll
            for (int j = 0; j < 16; ++j) { a1[j] = 0.f; a2[j] = 0.f; }
            float dsum = 0.f;
            for (int s8 = 0; s8 < 8; ++s8) { float sw8[8]; unpack8(*(LAS v4u*)(ring + L_SW + li * RS64 + s8 * 16), sw8);
                if (s8 == sub) {
#pragma unroll
                    for (int j = 0; j < 8; ++j) dsum += sw8[j]; }
#pragma unroll
                for (int j = 0; j < 8; ++j) { float v0[8], v1[8]; unpack8(*(LAS v4u*)(ring + L_V + (s8 * 8 + j) * RS128 + d0 * 2), v0); unpack8(*(LAS v4u*)(ring + L_V + (s8 * 8 + j) * RS128 + d0 * 2 + 16), v1);
#pragma unroll
                    for (int e = 0; e < 8; ++e) { a1[e] += sw8[j] * v0[e]; a1[8 + e] += sw8[j] * v1[e]; } } }
            float qn = 0.f;
            for (int cc = 0; cc < 16; ++cc) { float qv[8]; unpack8(*(LAS v4u*)(ring + L_Q + li * RS128 + cc * 16), qv);
                if ((cc >> 1) == sub) {
#pragma unroll
                    for (int e = 0; e < 8; ++e) qn += qv[e] * s_np[cc * 8 + e]; }
#pragma unroll
                for (int j = 0; j < 16; ++j) { float cv[8]; unpack8(*(LAS v4u*)(ring + L_CP + (d0 + j) * RS128 + cc * 16), cv);
#pragma unroll
                    for (int e = 0; e < 8; ++e) a2[j] += qv[e] * cv[e]; } }
            const float wq = s_wq[li];
            float den = dsum + wq * qn; den += __shfl_xor(den, 1); den += __shfl_xor(den, 2); den += __shfl_xor(den, 4);
            const float dn = fmaxf(fabsf(den), s_em[li]);
            LAS float* hb = (LAS float*)(ring + L_HB + li * RSH) + d0;
#pragma unroll
            for (int j = 0; j < 16; ++j) hb[j] = (a1[j] + wq * a2[j]) / dn;
        }
        __syncthreads();
        {
            const int li = F.tid >> 3, d0 = (F.tid & 7) * 16; const LAS float* hb = (const LAS float*)(ring + L_HB + li * RSH) + d0; float hv[16]; float ss = 0.f;
#pragma unroll
            for (int j = 0; j < 16; ++j) { hv[j] = hb[j]; ss += hv[j] * hv[j]; }
            ss += __shfl_xor(ss, 1); ss += __shfl_xor(ss, 2); ss += __shfl_xor(ss, 4);
            const float r = 1.f / sqrtf(ss * (1.f / MHD) + EPS);
            const size_t zr = (size_t)(m0 + li) * ZW + h * MHD + d0; float mo[16], mg[16], o[16];
            unpack8(*(const GAS v4u*)(Z + zr + ZC_MO), mo); unpack8(*(const GAS v4u*)(Z + zr + ZC_MO + 8), mo + 8);
            unpack8(*(const GAS v4u*)(Z + zr + ZC_MG), mg); unpack8(*(const GAS v4u*)(Z + zr + ZC_MG + 8), mg + 8);
#pragma unroll
            for (int j = 0; j < 16; ++j) o[j] = hv[j] * r * F.m_norm[l * MW + h * MHD + d0 + j] * sigmoidf_(mo[j]) * siluf_(mg[j]);
            bf16* yp = YM + (size_t)(m0 + li) * MW + h * MHD + d0;
            *(GAS v4u*)yp = pack8(o); *(GAS v4u*)(yp + 8) = pack8(o + 8); }
        __syncthreads();
    }
}

struct Args { const void* in[18]; float* out; unsigned char* ws; int ph_lo, ph_hi; };
constexpr int PH_PER_LAYER = 9, NPH = 1 + DEPTH * PH_PER_LAYER;

__global__ void __launch_bounds__(NWAVES * 64, 2) fwd(Args args) {
    extern __shared__ __attribute__((aligned(16))) unsigned char lds[];
    Frame F;
    F.lds = (LAS unsigned char*)lds;
    F.tid = threadIdx.x; F.lane = F.tid & 63; F.wave = __builtin_amdgcn_readfirstlane(F.tid >> 6);
    F.G = gridDim.x; { const int bx = blockIdx.x; F.vcu = (F.G % 8 == 0) ? (bx % 8) * (F.G / 8) + bx / 8 : bx; }
    F.ws = args.ws; F.out = args.out;
    F.x = (const float*)args.in[0]; F.p = (const float*)args.in[1]; F.pos = (const int*)args.in[2]; F.w_in = (const float*)args.in[3]; F.conv_w = (const float*)args.in[4];
    F.b_ig = (const float*)args.in[5]; F.b_fg = (const float*)args.in[6]; F.m_norm = (const float*)args.in[7]; F.sinks = (const float*)args.in[8];
    F.w_up0 = (const float*)args.in[9]; F.w_up1 = (const float*)args.in[10]; F.w_up2 = (const float*)args.in[11]; F.w_out = (const float*)args.in[12];
    F.pre_g = (const float*)args.in[13]; F.post_g = (const float*)args.in[14]; F.w_ple = (const float*)args.in[15]; F.w_pg = (const float*)args.in[16]; F.ple_g = (const float*)args.in[17];
    volatile LAS unsigned* MISC = (volatile LAS unsigned*)(F.lds + MISC_OFF);
    for (int u = F.tid; u < (LDS_BYTES - MISC_OFF) / 4; u += NWAVES * 64) ((LAS unsigned*)(F.lds + MISC_OFF))[u] = 0u;
    __syncthreads();
    unsigned* ctl = (unsigned*)(F.ws + WS_CTL);
    XcdBarrier bar; bar.bar = ctl + CW_BAR; bar.x = 0; bar.st = nullptr;
#if MK_ONE_LAUNCH
    bar = xcd_barrier_post(ctl + CW_BAR, MISC + 8);
#define GRID_BAR() xcd_barrier(bar)
#else
#define GRID_BAR() do { if (F.tid == 0) __hip_atomic_store((gu32*)(ctl + CW_TMO), 0xBADBA0u, RLX_AGENT); } while (0)
#endif
    const int lo = args.ph_lo, hi = args.ph_hi;
#define IN(k) (lo <= (k) && (k) < hi)
#define BOTH(k) (IN(k) && IN((k) + 1))

    if (IN(0)) { p0_prologue(F); if (BOTH(0)) GRID_BAR(); }

    for (int l = 0; l < DEPTH; ++l) {
        const int pb = 1 + l * PH_PER_LAYER;
        const bf16* Win_t = (const bf16*)(F.ws + WS_WIN) + (size_t)l * ZW * DM;
        if (IN(pb + 0)) {
            pg8::Gemm g{(const bf16*)(F.ws + WS_XB), Win_t, 0, 0, M, ZW, DM, 1};
            pg8::StaticOrder S; S.init(M, ZW, F.G, (int)blockIdx.x, 1);
            pg8::EpiBf16 E{(bf16*)(F.ws + WS_Z), ZW};
            pg8::gemm_phase<pg8::EpiBf16>(F.lds + RING_OFF, g, S, E);
            if (BOTH(pb + 0)) GRID_BAR();
        }
        if (IN(pb + 1)) {
            phase_conv(F, l);
            phase_attn_naive(F, l);
            phase_m1(F, l);
            if (BOTH(pb + 1)) GRID_BAR();
        }
        if (IN(pb + 2)) { phase_m2(F); if (BOTH(pb + 2)) GRID_BAR(); }
        if (IN(pb + 3)) { phase_m3(F, l); if (BOTH(pb + 3)) GRID_BAR(); }
        if (IN(pb + 4)) {
            static_assert(WS_YM - WS_YC == WS_YA - WS_YM, "branch outputs equally spaced");
            pg8::Gemm g{(const bf16*)(F.ws + WS_YC), (const bf16*)(F.ws + WS_WUP) + (size_t)l * 3 * DM * 1024, WS_YM - WS_YC, (size_t)DM * 1024 * 2, M, DM, 1024, 3};
            pg8::StaticOrder S; S.init(M, DM, F.G, (int)blockIdx.x, 3);
            pg8::EpiMerge E{(const bf16*)(F.ws + WS_Z) + ZC_GT, ZW, DM, (bf16*)(F.ws + WS_MRG), DM};
            pg8::gemm_phase<pg8::EpiMerge>(F.lds + RING_OFF, g, S, E);
            if (BOTH(pb + 4)) GRID_BAR();
        }
        if (IN(pb + 5)) {
            pg8::Gemm g{(const bf16*)(F.ws + WS_MRG), (const bf16*)(F.ws + WS_WOUT) + (size_t)l * DM * DM, 0, 0, M, DM, DM, 1};
            pg8::StaticOrder S; S.init(M, DM, F.G, (int)blockIdx.x, 1);
            pg8::EpiF32 E{(float*)(F.ws + WS_YT), DM};
            pg8::gemm_phase<pg8::EpiF32>(F.lds + RING_OFF, g, S, E);
            if (BOTH(pb + 5)) GRID_BAR();
        }
        if (IN(pb + 6)) { phase_norm1(F, l); if (BOTH(pb + 6)) GRID_BAR(); }
        if (IN(pb + 7)) {
            { pg8::Gemm g{(const bf16*)(F.ws + WS_PB) + (size_t)l * M * PLE, (const bf16*)(F.ws + WS_WPLE) + (size_t)l * DM * PLE, 0, 0, M, DM, PLE, 1};
              pg8::StaticOrder S; S.init(M, DM, F.G, (int)blockIdx.x, 1);
              pg8::EpiBf16 E{(bf16*)(F.ws + WS_E), DM};
              pg8::gemm_phase<pg8::EpiBf16>(F.lds + RING_OFF, g, S, E); }
            VM_WAIT(); __syncthreads();
            { pg8::Gemm g{(const bf16*)(F.ws + WS_XB), (const bf16*)(F.ws + WS_WG) + (size_t)l * DM * DM, 0, 0, M, DM, DM, 1};
              pg8::StaticOrder S; S.init(M, DM, F.G, (int)blockIdx.x, 1);
              pg8::EpiGateMul E{(const bf16*)(F.ws + WS_E), DM, (float*)(F.ws + WS_YT), DM};
              pg8::gemm_phase<pg8::EpiGateMul>(F.lds + RING_OFF, g, S, E); }
            if (BOTH(pb + 7)) GRID_BAR();
        }
        if (IN(pb + 8)) { phase_norm2(F, l); if (BOTH(pb + 8)) GRID_BAR(); }
    }
#undef IN
#undef BOTH
}

extern "C" void kernel_launch(void* const* d_in, const int* in_sizes, int n_in, void* d_out, int out_size, void* d_ws, size_t ws_size, hipStream_t stream) {
    static int grid = 0;
    if (grid == 0) {
        if (n_in != 18 || out_size != M * DM || ws_size < WS_END) { fprintf(stderr, "kernel_launch: unexpected shapes (n_in %d, out %d, ws %zu)\n", n_in, out_size, ws_size); grid = -1; return; }
        int dev = 0, cus = 0, per_cu = 0;
        if (hipGetDevice(&dev) != hipSuccess || hipDeviceGetAttribute(&cus, hipDeviceAttributeMultiprocessorCount, dev) != hipSuccess) { grid = -1; return; }
        if (hipFuncSetAttribute((const void*)fwd, hipFuncAttributeMaxDynamicSharedMemorySize, LDS_BYTES) != hipSuccess) { fprintf(stderr, "kernel_launch: hipFuncSetAttribute failed\n"); grid = -1; return; }
        if (hipOccupancyMaxActiveBlocksPerMultiprocessor(&per_cu, (const void*)fwd, NWAVES * 64, LDS_BYTES) != hipSuccess || per_cu < 1) fprintf(stderr, "kernel_launch: occupancy query says %d\n", per_cu);
        (void)hipGetLastError();
        grid = cus;
    }
    if (grid < 0) return;
    (void)hipMemsetAsync((char*)d_ws + WS_CTL, 0, CTL_ZERO_BYTES, stream);
    Args a{};
    for (int i = 0; i < 18; ++i) a.in[i] = d_in[i];
    a.out = (float*)d_out; a.ws = (unsigned char*)d_ws;
#if MK_ONE_LAUNCH
    a.ph_lo = 0; a.ph_hi = NPH;
    hipLaunchKernelGGL(fwd, dim3(grid), dim3(NWAVES * 64), LDS_BYTES, stream, a);
#else
    for (int ph = 0; ph < NPH; ++ph) { a.ph_lo = ph; a.ph_hi = ph + 1; hipLaunchKernelGGL(fwd, dim3(grid), dim3(NWAVES * 64), LDS_BYTES, stream, a); }
#endif
}
```

```cpp
#include <hip/hip_runtime.h>
#include <cstdio>
#include <cstdint>

#ifndef MK_ONE_LAUNCH
#define MK_ONE_LAUNCH 1
#endif
#ifndef NAIVE_ATTN
#define NAIVE_ATTN 0
#endif
#ifndef NAIVE_MLSTM
#define NAIVE_MLSTM 0
#endif

namespace pg8 {
#define PG8_LAS __attribute__((address_space(3)))
typedef unsigned short bf16_t;
typedef short bf16x8 __attribute__((ext_vector_type(8)));
typedef float f32x4 __attribute__((ext_vector_type(4)));
typedef unsigned u32x4 __attribute__((ext_vector_type(4)));
typedef unsigned u32x2 __attribute__((ext_vector_type(2)));
constexpr int BM = 256, BK = 64, HALF = 128, HTB = HALF * BK * 2, STAGE_BYTES = 8 * HTB, NXCD = 8, WGM = 8;

__host__ __device__ __forceinline__ int lds_byte(int r, int c) { const int st = (r >> 4) * 2 + (c >> 5), rr = r & 15, cc = c & 31, ob = rr * 64 + cc * 2; return st * 1024 + (ob ^ (((ob >> 9) & 1) << 5)); }
__host__ __device__ __forceinline__ void stage_rc(int b, int& R, int& C) { const int st = b / 1024, sb = b % 1024, swz = sb ^ (((sb >> 9) & 1) << 5); R = (st >> 1) * 16 + swz / 64; C = (st & 1) * 32 + (swz % 64) / 2; }
__host__ __device__ __forceinline__ int perm32(int rho) { const int n = rho >> 4, i = rho & 15; return 8 * (i >> 2) + 4 * n + (i & 3); }

struct Unit { int pm, pn, br; };
struct Gemm { const bf16_t* A; const bf16_t* Bt; size_t brA, brB; int M, N, K, nbr;
    __device__ __forceinline__ const char* a(int br) const { return (const char*)A + (size_t)br * brA; }
    __device__ __forceinline__ const char* b(int br) const { return (const char*)Bt + (size_t)br * brB; } };

struct StaticOrder {
    int nM, nN, nwg, G, c, nbr;
    __host__ __device__ void init(int M, int N, int G_, int c_, int nbr_) { nM = M / BM; nN = N / BM; nwg = nM * nN; G = G_; c = c_; nbr = nbr_; }
    __host__ __device__ bool next(int i, Unit& u) const {
        const int it = i / nbr; u.br = i - it * nbr;
        const long L = (long)it * G + c; if (L >= nwg) return false;
        int wgid = (int)L; { const int q = nwg / NXCD, r = nwg % NXCD, xcd = wgid % NXCD, off = wgid / NXCD; wgid = (xcd < r ? xcd * (q + 1) : r * (q + 1) + (xcd - r) * q) + off; }
        const int nig = WGM * nN, gid = wgid / nig, fm = gid * WGM, gsz = (nM - fm) < WGM ? (nM - fm) : WGM;
        u.pm = fm + ((wgid % nig) % gsz); u.pn = (wgid % nig) / gsz; return true;
    }
};

__device__ __forceinline__ unsigned cvt_pk_bf16(float lo, float hi) { unsigned r; asm volatile("v_cvt_pk_bf16_f32 %0, %1, %2" : "=v"(r) : "v"(lo), "v"(hi)); return r; }
__device__ __forceinline__ float bflo(unsigned w) { return __uint_as_float(w << 16); }
__device__ __forceinline__ float bfhi(unsigned w) { return __uint_as_float(w & 0xffff0000u); }

typedef f32x4 AccT[2][2][4][2];

struct EpiBf16 {
    static constexpr bool PERM = true;
    bf16_t* O; int ldc;
    __device__ __forceinline__ bool keep(const Unit&) const { return false; }
    __device__ __forceinline__ void operator()(AccT& acc, const Unit& u, int wr, int wc, int fr, int fq) const {
        const int row0 = u.pm * BM + wr * 64 + fr, col0 = u.pn * BM + wc * 32 + 8 * fq;
#pragma unroll
        for (int ai = 0; ai < 2; ++ai)
#pragma unroll
            for (int m = 0; m < 4; ++m) { bf16_t* rowp = O + (size_t)(row0 + ai * HALF + m * 16) * ldc + col0;
#pragma unroll
                for (int bj = 0; bj < 2; ++bj) { const f32x4 v0 = acc[ai][bj][m][0], v1 = acc[ai][bj][m][1];
                    u32x4 w; w.x = cvt_pk_bf16(v0[0], v0[1]); w.y = cvt_pk_bf16(v0[2], v0[3]); w.z = cvt_pk_bf16(v1[0], v1[1]); w.w = cvt_pk_bf16(v1[2], v1[3]);
                    *(u32x4*)(rowp + bj * HALF) = w; } }
    }
};
struct EpiF32 {
    static constexpr bool PERM = false;
    float* C; int ldc;
    __device__ __forceinline__ bool keep(const Unit&) const { return false; }
    __device__ __forceinline__ void operator()(AccT& acc, const Unit& u, int wr, int wc, int fr, int fq) const {
        const int row0 = u.pm * BM + wr * 64 + fr, col0 = u.pn * BM + wc * 32 + 4 * fq;
#pragma unroll
        for (int ai = 0; ai < 2; ++ai)
#pragma unroll
            for (int m = 0; m < 4; ++m) { float* rowp = C + (size_t)(row0 + ai * HALF + m * 16) * ldc + col0;
#pragma unroll
                for (int bj = 0; bj < 2; ++bj)
#pragma unroll
                    for (int n = 0; n < 2; ++n) *(f32x4*)(rowp + bj * HALF + n * 16) = acc[ai][bj][m][n]; }
    }
};
struct EpiMerge {
    static constexpr bool PERM = true;
    const bf16_t* G; int ldg; int gstride;
    bf16_t* O; int ldo;
    __device__ __forceinline__ bool keep(const Unit& u) const { return u.br < 2; }
    __device__ __forceinline__ void operator()(AccT& acc, const Unit& u, int wr, int wc, int fr, int fq) const {
        const int row0 = u.pm * BM + wr * 64 + fr, col0 = u.pn * BM + wc * 32 + 8 * fq;
#pragma unroll
        for (int ai = 0; ai < 2; ++ai)
#pragma unroll
            for (int m = 0; m < 4; ++m) { const size_t row = (size_t)(row0 + ai * HALF + m * 16);
#pragma unroll
                for (int bj = 0; bj < 2; ++bj) {
                    const bf16_t* gp = G + row * ldg + u.br * gstride + col0 + bj * HALF;
                    const u32x4 za = *(const u32x4*)gp;
                    float ea[8]; { const unsigned w[4] = {za.x, za.y, za.z, za.w};
#pragma unroll
                        for (int j = 0; j < 4; ++j) { ea[2 * j] = __expf(-bflo(w[j])); ea[2 * j + 1] = __expf(-bfhi(w[j])); } }
                    float f[8];
                    if (u.br < 2) { const u32x4 zb = *(const u32x4*)(gp + gstride); const unsigned w[4] = {zb.x, zb.y, zb.z, zb.w};
#pragma unroll
                        for (int j = 0; j < 4; ++j) { f[2 * j] = (1.f + __expf(-bflo(w[j]))) / (1.f + ea[2 * j]); f[2 * j + 1] = (1.f + __expf(-bfhi(w[j]))) / (1.f + ea[2 * j + 1]); } }
                    else {
#pragma unroll
                        for (int j = 0; j < 8; ++j) f[j] = 1.f / (1.f + ea[j]); }
                    f32x4 v0 = acc[ai][bj][m][0], v1 = acc[ai][bj][m][1];
                    v0 = v0 * (f32x4){f[0], f[1], f[2], f[3]}; v1 = v1 * (f32x4){f[4], f[5], f[6], f[7]};
                    if (u.br < 2) { acc[ai][bj][m][0] = v0; acc[ai][bj][m][1] = v1; }
                    else { u32x4 w; w.x = cvt_pk_bf16(v0[0], v0[1]); w.y = cvt_pk_bf16(v0[2], v0[3]); w.z = cvt_pk_bf16(v1[0], v1[1]); w.w = cvt_pk_bf16(v1[2], v1[3]);
                        *(u32x4*)(O + row * ldo + col0 + bj * HALF) = w; } } }
    }
};
struct EpiGateMul {
    static constexpr bool PERM = true;
    const bf16_t* E; int lde; float* T; int ldc;
    __device__ __forceinline__ bool keep(const Unit&) const { return false; }
    __device__ __forceinline__ void operator()(AccT& acc, const Unit& u, int wr, int wc, int fr, int fq) const {
        const int row0 = u.pm * BM + wr * 64 + fr, col0 = u.pn * BM + wc * 32 + 8 * fq;
#pragma unroll
        for (int ai = 0; ai < 2; ++ai)
#pragma unroll
            for (int m = 0; m < 4; ++m) { const size_t row = (size_t)(row0 + ai * HALF + m * 16);
#pragma unroll
                for (int bj = 0; bj < 2; ++bj) {
                    const u32x4 ev = *(const u32x4*)(E + row * lde + col0 + bj * HALF);
                    const f32x4 e0 = (f32x4){bflo(ev.x), bfhi(ev.x), bflo(ev.y), bfhi(ev.y)}, e1 = (f32x4){bflo(ev.z), bfhi(ev.z), bflo(ev.w), bfhi(ev.w)};
                    f32x4 v0 = acc[ai][bj][m][0], v1 = acc[ai][bj][m][1];
#pragma unroll
                    for (int j = 0; j < 4; ++j) { v0[j] = e0[j] / (1.f + __expf(-v0[j])); v1[j] = e1[j] / (1.f + __expf(-v1[j])); }
                    float* tp = T + row * ldc + col0 + bj * HALF;
                    *(f32x4*)tp = v0; *(f32x4*)(tp + 4) = v1; } }
    }
};

template <class Epi, bool ALIGN_EPI = true, bool SP2 = true>
__device__ __forceinline__ void gemm_phase(PG8_LAS unsigned char* lds, const Gemm g, const StaticOrder& S, const Epi& E) {
    int tid = threadIdx.x; asm volatile("" : "+v"(tid));
    const int wid = __builtin_amdgcn_readfirstlane(tid >> 6), lane = tid & 63, wr = wid >> 2, wc = wid & 3, fr = lane & 15, fq = lane >> 4;
    const int K = g.K, nt = K / BK;
    unsigned voffA[2], voffB[2];
#pragma unroll
    for (int i = 0; i < 2; ++i) { int R, C; stage_rc(tid * 16 + i * 8192, R, C); const int Rb = Epi::PERM ? ((R & ~31) + perm32(R & 31)) : R;
        voffA[i] = (unsigned)(R * K + C) * 2u; voffB[i] = (unsigned)(Rb * K + C) * 2u; }
    const size_t kstep = (size_t)(BK * 2);
    const size_t hstep = (size_t)HALF * K * 2;
    const size_t tstep = 2 * hstep;
    const unsigned ldsw = (unsigned)wid * 1024u;
    const int aoff = lds_byte(wr * 64 + fr, fq * 8), boff = lds_byte(wc * 32 + fr, fq * 8);
#define PG8_SA(b, h) (((b) * 2 + (h)) * HTB)
#define PG8_SB(b, h) ((4 + (b) * 2 + (h)) * HTB)
#define PG8_STAGE(bufoff, gbase, voff) do { _Pragma("unroll") for (int _i = 0; _i < 2; ++_i) \
        __builtin_amdgcn_global_load_lds((const unsigned*)((const char*)(gbase) + (voff)[_i]), (PG8_LAS unsigned*)(lds + (bufoff) + ldsw + _i * 8192), 16, 0, 0); } while (0)
#define PG8_LDA(dst, b, h) do { _Pragma("unroll") for (int m = 0; m < 4; ++m) _Pragma("unroll") for (int k = 0; k < 2; ++k) dst[m][k] = *(const PG8_LAS bf16x8*)(lds + PG8_SA(b, h) + aoff + m * 2048 + k * 1024); } while (0)
#define PG8_LDB(dst, b, h) do { _Pragma("unroll") for (int n = 0; n < 2; ++n) _Pragma("unroll") for (int k = 0; k < 2; ++k) dst[n][k] = *(const PG8_LAS bf16x8*)(lds + PG8_SB(b, h) + boff + n * 2048 + k * 1024); } while (0)
#define PG8_MMA(ai, bj, At, Bt) do { __builtin_amdgcn_s_setprio(1); _Pragma("unroll") for (int m = 0; m < 4; ++m) _Pragma("unroll") for (int n = 0; n < 2; ++n) _Pragma("unroll") for (int k = 0; k < 2; ++k) \
        acc[ai][bj][m][n] = __builtin_amdgcn_mfma_f32_16x16x32_bf16(Bt[n][k], At[m][k], acc[ai][bj][m][n], 0, 0, 0); __builtin_amdgcn_s_setprio(0); } while (0)
#define PG8_WAIT_V(n) asm volatile("s_waitcnt vmcnt(" #n ")" ::: "memory")
#define PG8_WAIT_L(n) asm volatile("s_waitcnt lgkmcnt(" #n ")" ::: "memory")
#define PG8_BAR __builtin_amdgcn_s_barrier()
#define PG8_SCHED __builtin_amdgcn_sched_barrier(0)
    Unit cur, nxt; int ui = 0;
    if (!S.next(0, cur)) return;
    AccT acc;
#pragma unroll
    for (int a = 0; a < 2; ++a)
#pragma unroll
        for (int b = 0; b < 2; ++b)
#pragma unroll
            for (int m = 0; m < 4; ++m)
#pragma unroll
                for (int n = 0; n < 2; ++n) acc[a][b][m][n] = (f32x4){0.f, 0.f, 0.f, 0.f};
    bf16x8 At[4][2], B0[2][2], B1[2][2];
    const char* cA = g.a(cur.br) + (size_t)cur.pm * tstep; const char* cB = g.b(cur.br) + (size_t)cur.pn * tstep;
    if constexpr (SP2) {
        PG8_STAGE(PG8_SB(0, 0), cB, voffB); PG8_STAGE(PG8_SB(0, 1), cB + hstep, voffB); PG8_STAGE(PG8_SA(0, 0), cA, voffA); PG8_STAGE(PG8_SA(0, 1), cA + hstep, voffA);
        if (wr == 1) PG8_BAR;
        PG8_WAIT_V(2); PG8_BAR;
        PG8_STAGE(PG8_SB(1, 0), cB + kstep, voffB); PG8_STAGE(PG8_SA(1, 0), cA + kstep, voffA); PG8_STAGE(PG8_SB(1, 1), cB + hstep + kstep, voffB);
        PG8_WAIT_V(6); PG8_BAR;
    } else {
        PG8_STAGE(PG8_SB(0, 0), cB, voffB); PG8_STAGE(PG8_SA(0, 0), cA, voffA); PG8_STAGE(PG8_SB(0, 1), cB + hstep, voffB); PG8_STAGE(PG8_SA(0, 1), cA + hstep, voffA);
        if (wr == 1) PG8_BAR;
        PG8_WAIT_V(4); PG8_BAR;
        PG8_STAGE(PG8_SB(1, 0), cB + kstep, voffB); PG8_STAGE(PG8_SA(1, 0), cA + kstep, voffA); PG8_STAGE(PG8_SB(1, 1), cB + hstep + kstep, voffB);
        PG8_WAIT_V(6); PG8_BAR;
    }
    for (;;) {
        const bool has_next = S.next(ui + 1, nxt);
        const char* nA = has_next ? g.a(nxt.br) + (size_t)nxt.pm * tstep : cA; const char* nB = has_next ? g.b(nxt.br) + (size_t)nxt.pn * tstep : cB;
        for (int t = 0; t < nt; t += 2) {
            const bool last = (t == nt - 2);
            const char* a1 = cA + (size_t)(t + 1) * kstep;
            const char* a2 = last ? nA : cA + (size_t)(t + 2) * kstep; const char* b2 = last ? nB : cB + (size_t)(t + 2) * kstep;
            const char* a3 = a2 + kstep; const char* b3 = b2 + kstep;
            if constexpr (SP2) {
            PG8_LDB(B0, 0, 0); PG8_LDB(B1, 0, 1); PG8_SCHED; PG8_LDA(At, 0, 0); PG8_STAGE(PG8_SA(1, 1), a1 + hstep, voffA);
            PG8_WAIT_V(8); PG8_WAIT_L(0); PG8_BAR; PG8_MMA(0, 0, At, B0); PG8_MMA(0, 1, At, B1); PG8_BAR; PG8_SCHED;
            PG8_LDA(At, 0, 1); PG8_STAGE(PG8_SB(0, 0), b2, voffB); PG8_STAGE(PG8_SB(0, 1), b2 + hstep, voffB); PG8_STAGE(PG8_SA(0, 0), a2, voffA);
            PG8_WAIT_V(8); PG8_WAIT_L(0); PG8_BAR; PG8_MMA(1, 0, At, B0); PG8_MMA(1, 1, At, B1); PG8_BAR; PG8_SCHED;
            PG8_LDB(B0, 1, 0); PG8_LDB(B1, 1, 1); PG8_SCHED; PG8_LDA(At, 1, 0); PG8_STAGE(PG8_SA(0, 1), a2 + hstep, voffA);
            PG8_WAIT_V(8); PG8_WAIT_L(0); PG8_BAR; PG8_MMA(0, 0, At, B0); PG8_MMA(0, 1, At, B1); PG8_BAR; PG8_SCHED;
            PG8_LDA(At, 1, 1); PG8_STAGE(PG8_SB(1, 0), b3, voffB); PG8_STAGE(PG8_SB(1, 1), b3 + hstep, voffB); PG8_STAGE(PG8_SA(1, 0), a3, voffA);
            PG8_WAIT_V(8); PG8_WAIT_L(0); PG8_BAR; PG8_MMA(1, 0, At, B0); PG8_MMA(1, 1, At, B1); PG8_BAR; PG8_SCHED;
            } else {
            PG8_LDB(B0, 0, 0); PG8_SCHED; PG8_LDA(At, 0, 0); PG8_STAGE(PG8_SA(1, 1), a1 + hstep, voffA);
            PG8_WAIT_L(8); PG8_BAR; PG8_WAIT_L(0); PG8_MMA(0, 0, At, B0); PG8_BAR; PG8_SCHED;
            PG8_LDB(B1, 0, 1); PG8_STAGE(PG8_SB(0, 0), b2, voffB);
            PG8_BAR; PG8_WAIT_L(0); PG8_MMA(0, 1, At, B1); PG8_BAR;
            PG8_LDA(At, 0, 1); PG8_STAGE(PG8_SA(0, 0), a2, voffA);
            PG8_BAR; PG8_WAIT_L(0); PG8_MMA(1, 0, At, B0); PG8_BAR; PG8_SCHED;
            PG8_STAGE(PG8_SB(0, 1), b2 + hstep, voffB);
            PG8_WAIT_V(6); PG8_BAR; PG8_MMA(1, 1, At, B1); PG8_BAR;
            PG8_LDB(B0, 1, 0); PG8_SCHED; PG8_LDA(At, 1, 0); PG8_STAGE(PG8_SA(0, 1), a2 + hstep, voffA);
            PG8_WAIT_L(8); PG8_BAR; PG8_WAIT_L(0); PG8_MMA(0, 0, At, B0); PG8_BAR; PG8_SCHED;
            PG8_LDB(B1, 1, 1); PG8_STAGE(PG8_SB(1, 0), b3, voffB);
            PG8_BAR; PG8_WAIT_L(0); PG8_MMA(0, 1, At, B1); PG8_BAR;
            PG8_LDA(At, 1, 1); PG8_STAGE(PG8_SA(1, 0), a3, voffA);
            PG8_BAR; PG8_WAIT_L(0); PG8_MMA(1, 0, At, B0); PG8_BAR; PG8_SCHED;
            PG8_STAGE(PG8_SB(1, 1), b3 + hstep, voffB);
            PG8_WAIT_V(6); PG8_BAR; PG8_MMA(1, 1, At, B1); PG8_BAR;
            }
        }
        if constexpr (ALIGN_EPI) { if (wr == 0) PG8_BAR; }
        E(acc, cur, wr, wc, fr, fq);
        if (!has_next) break;
        if (!E.keep(cur)) {
#pragma unroll
        for (int a = 0; a < 2; ++a)
#pragma unroll
            for (int b = 0; b < 2; ++b)
#pragma unroll
                for (int m = 0; m < 4; ++m)
#pragma unroll
                    for (int n = 0; n < 2; ++n) acc[a][b][m][n] = (f32x4){0.f, 0.f, 0.f, 0.f};
        }
        cur = nxt; cA = nA; cB = nB; ++ui;
        if constexpr (ALIGN_EPI) { if (wr == 1) PG8_BAR; }
    }
    PG8_WAIT_V(0);
    if constexpr (!ALIGN_EPI) { if (wr == 0) PG8_BAR; }
    PG8_BAR;
#undef PG8_SA
#undef PG8_SB
#undef PG8_STAGE
#undef PG8_LDA
#undef PG8_LDB
#undef PG8_MMA
#undef PG8_WAIT_V
#undef PG8_WAIT_L
#undef PG8_BAR
#undef PG8_SCHED
}
}

constexpr int NWAVES = 8;
constexpr int DM = 2048, NB = 4, SEQ = 4096, M = NB * SEQ, DEPTH = 4, PLE = 256;
constexpr int CCH = 1024, MH = 8, MHD = 128, MW = 1024, LCH = 64, NCH = SEQ / LCH;
constexpr int AQH = 16, AKVH = 4, AHD = 64, AQW = 1024, AKVW = 256, AWIN = 128;
constexpr int INW = 17936, ZW = 18176;
constexpr float EPS = 1e-6f;
constexpr int ZC_CB = 0, ZC_CC = 1024, ZC_CX = 2048, ZC_CG = 3072, ZC_MQ = 4096, ZC_MK = 5120, ZC_MV = 6144, ZC_MO = 7168, ZC_MG = 8192,
              ZC_AQ = 9216, ZC_AK = 10240, ZC_AV = 10496, ZC_AG = 10752, ZC_GT = 11776, ZC_MI = 17920, ZC_MF = 17928;
__host__ __device__ __forceinline__ int zsrc(int n) { return n < 8192 ? n : (n < 17920 ? n + 16 : (n < INW ? n - 17920 + 8192 : -1)); }

constexpr size_t MiB = 1u << 20;
constexpr size_t WS_CTL = 0, CTL_ZERO_BYTES = 1 * MiB;
constexpr size_t WS_ROPE = 1 * MiB;
constexpr size_t WS_PB = 5 * MiB;
constexpr size_t WS_WIN = 37 * MiB;
constexpr size_t WS_WUP = 321 * MiB;
constexpr size_t WS_WOUT = 369 * MiB;
constexpr size_t WS_WG = 401 * MiB;
constexpr size_t WS_WPLE = 433 * MiB;
constexpr size_t WS_XB = 437 * MiB;
constexpr size_t WS_Z = 501 * MiB;
constexpr size_t WS_YC = 1069 * MiB, WS_YM = 1101 * MiB, WS_YA = 1133 * MiB;
constexpr size_t WS_MRG = 1165 * MiB;
constexpr size_t WS_YT = 1229 * MiB;
constexpr size_t WS_E = 1357 * MiB;
constexpr size_t WS_CST = 1421 * MiB;
constexpr size_t WS_NST = 1549 * MiB;
constexpr size_t WS_SCL = 1550 * MiB;
constexpr size_t WS_END = 1551 * MiB;
constexpr int CW_TMO = 0, CW_BAR = 4096;

constexpr int RING_OFF = 0, RING_BYTES = 131072;
constexpr int SCAL_OFF = RING_BYTES;
constexpr int MISC_OFF = SCAL_OFF + 8192;
constexpr int LDS_BYTES = 147456;

#define GAS __attribute__((address_space(1)))
#define LAS __attribute__((address_space(3)))
typedef unsigned short bf16;
typedef unsigned v4u __attribute__((ext_vector_type(4)));
typedef unsigned v2u __attribute__((ext_vector_type(2)));
typedef float f32x4 __attribute__((ext_vector_type(4)));
typedef float f32x16 __attribute__((ext_vector_type(16)));
typedef short bf16x8 __attribute__((ext_vector_type(8)));
typedef GAS unsigned gu32;
#define RLX_AGENT __ATOMIC_RELAXED, __HIP_MEMORY_SCOPE_AGENT
#define LDS_WAIT() asm volatile("s_waitcnt lgkmcnt(0)" ::: "memory")
#define VM_WAIT() asm volatile("s_waitcnt vmcnt(0)" ::: "memory")
__device__ __forceinline__ unsigned f2bf(float f) { unsigned u = __builtin_bit_cast(unsigned, f); return (u + 0x7fffu + ((u >> 16) & 1u)) >> 16; }
__device__ __forceinline__ unsigned pk2(float lo, float hi) { return f2bf(lo) | (f2bf(hi) << 16); }
__device__ __forceinline__ float bf2f(unsigned short b) { return __uint_as_float(((unsigned)b) << 16); }
__device__ __forceinline__ float bflo(unsigned w) { return __uint_as_float(w << 16); }
__device__ __forceinline__ float bfhi(unsigned w) { return __uint_as_float(w & 0xffff0000u); }
__device__ __forceinline__ void unpack8(const v4u w, float* f) { f[0] = bflo(w.x); f[1] = bfhi(w.x); f[2] = bflo(w.y); f[3] = bfhi(w.y); f[4] = bflo(w.z); f[5] = bfhi(w.z); f[6] = bflo(w.w); f[7] = bfhi(w.w); }
__device__ __forceinline__ v4u pack8(const float* f) { v4u w; w.x = pk2(f[0], f[1]); w.y = pk2(f[2], f[3]); w.z = pk2(f[4], f[5]); w.w = pk2(f[6], f[7]); return w; }
__device__ __forceinline__ float sigmoidf_(float x) { return 1.f / (1.f + __expf(-x)); }
__device__ __forceinline__ float siluf_(float x) { return x / (1.f + __expf(-x)); }

#define XB_TMO      128
#define XB_XCNT(j)  (256  + 64 * (j))
#define XB_XSUB(j)  (1280 + 64 * (j))
#define XB_XGEN(j)  (2304 + 64 * (j))
#define XB_TOP      3328
#define XB_TOPGEN   3392
#define XCD_BAR_WORDS 3456
#define XB_SPIN_CAP (1u << 18)
__device__ __forceinline__ unsigned xb_ld(unsigned* p)              { return __hip_atomic_load(p, __ATOMIC_RELAXED, __HIP_MEMORY_SCOPE_AGENT); }
__device__ __forceinline__ unsigned xb_add(unsigned* p, unsigned v) { return __hip_atomic_fetch_add(p, v, __ATOMIC_RELAXED, __HIP_MEMORY_SCOPE_AGENT); }
__device__ __forceinline__ unsigned xb_xcc_id() { return (unsigned)__builtin_amdgcn_s_getreg((3 << 11) | 20) & 0xFu; }
#define XB_SPIN(cond, bar) do { unsigned _sp = 0; while (cond) { __builtin_amdgcn_s_sleep(1); \
    if ((++_sp & 255u) == 0u) { if (xb_ld(&(bar)[XB_TMO])) break; if (_sp > XB_SPIN_CAP) { atomicAdd(&(bar)[XB_TMO], 1u); break; } } } } while (0)
struct XcdBarrier { unsigned* bar; unsigned x; volatile LAS unsigned* st; };
__device__ __forceinline__ XcdBarrier xcd_barrier_post(unsigned* bar, volatile LAS unsigned* st) {
    XcdBarrier b; b.bar = bar; b.x = xb_xcc_id(); b.st = st;
    if (threadIdx.x == 0) (void)xb_add(&bar[XB_XCNT(b.x)], 1u);
    return b;
}
__device__ __forceinline__ void xcd_barrier_complete(unsigned* bar, unsigned x, unsigned& nloc, unsigned& nx) {
    const unsigned G = gridDim.x * gridDim.y * gridDim.z;
    unsigned sum, cnt, mine, sp = 0u;
    for (;;) {
        sum = 0u; cnt = 0u; mine = 0u;
#pragma unroll
        for (unsigned j = 0; j < 16; ++j) { const unsigned c = xb_ld(&bar[XB_XCNT(j)]); sum += c; cnt += (c > 0u) ? 1u : 0u; mine = (j == x) ? c : mine; }
        if (sum == G) break;
        __builtin_amdgcn_s_sleep(1);
        if ((++sp & 255u) == 0u) { if (xb_ld(&bar[XB_TMO])) break; if (sp > XB_SPIN_CAP) { atomicAdd(&bar[XB_TMO], 1u); break; } }
    }
    nloc = mine > 0u ? mine : 1u; nx = cnt > 0u ? cnt : 1u;
}
__device__ __forceinline__ void xcd_barrier(const XcdBarrier& b) {
    asm volatile("s_waitcnt vmcnt(0)" ::: "memory");
    __syncthreads();
    if (threadIdx.x == 0) {
        unsigned* bar = b.bar;
        __builtin_amdgcn_s_waitcnt(0);
        unsigned nloc = b.st[0], nx = b.st[1];
        if (nloc == 0u) { xcd_barrier_complete(bar, b.x, nloc, nx); b.st[0] = nloc; b.st[1] = nx; }
        const unsigned old = xb_add(&bar[XB_XSUB(b.x)], 1u);
        const unsigned gen = old / nloc;
        if (old + 1u == (gen + 1u) * nloc) {
            __builtin_amdgcn_fence(__ATOMIC_RELEASE, "agent");
            asm volatile("s_waitcnt vmcnt(0)" ::: "memory");
            const unsigned og = xb_add(&bar[XB_TOP], 1u);
            const unsigned tg = og / nx;
            if (og + 1u == (tg + 1u) * nx) xb_add(&bar[XB_TOPGEN], 1u);
            else XB_SPIN(xb_ld(&bar[XB_TOPGEN]) == tg, bar);
            __builtin_amdgcn_fence(__ATOMIC_ACQUIRE, "agent");
            xb_add(&bar[XB_XGEN(b.x)], 1u);
            asm volatile("s_waitcnt vmcnt(0)" ::: "memory");
        } else {
            XB_SPIN(xb_ld(&bar[XB_XGEN(b.x)]) == gen, bar);
            __builtin_amdgcn_fence(__ATOMIC_ACQUIRE, "agent");
            asm volatile("s_waitcnt vmcnt(0)" ::: "memory");
        }
    }
    __syncthreads();
}

struct Frame {
    LAS unsigned char* lds;
    int tid, lane, wave;
    int vcu, G;
    unsigned char* ws;
    float* out;
    const float* x; const float* p; const int* pos; const float* w_in; const float* conv_w; const float* b_ig; const float* b_fg; const float* m_norm; const float* sinks;
    const float *w_up0, *w_up1, *w_up2; const float* w_out; const float* pre_g; const float* post_g; const float* w_ple; const float* w_pg; const float* ple_g;
};
__device__ __forceinline__ void relaunder(Frame& F) { int t = threadIdx.x; asm volatile("" : "+v"(t)); F.tid = t; F.lane = t & 63; F.wave = __builtin_amdgcn_readfirstlane(t >> 6); }
__device__ __forceinline__ float wave_sum(float v) {
#pragma unroll
    for (int o = 1; o < 64; o <<= 1) v += __shfl_xor(v, o);
    return v;
}
__device__ __forceinline__ float wave_max(float v) {
#pragma unroll
    for (int o = 1; o < 64; o <<= 1) v = fmaxf(v, __shfl_xor(v, o));
    return v;
}

template <bool ZMAP>
__device__ __forceinline__ void p0_transpose_item(const float* W, int K, int Nsrc, int Ndst, bf16* WT, LAS float* scr, int item, int lane) {
    const int nblk = Ndst / 32, kb = item / nblk, nb = item % nblk, k0 = 64 * kb, n0 = 32 * nb;
    const int nd = n0 + (lane & 31); const int ns = ZMAP ? zsrc(nd) : nd;
#pragma unroll 8
    for (int i = 0; i < 32; ++i) { const int kk = 2 * i + (lane >> 5); scr[kk * 33 + (lane & 31)] = ns >= 0 ? W[(size_t)(k0 + kk) * Nsrc + ns] : 0.f; }
    LDS_WAIT(); asm volatile("" ::: "memory");
    const int c = lane & 7;
#pragma unroll
    for (int j = 0; j < 4; ++j) { const int n = (lane >> 3) + 8 * j; const LAS float* s = scr + (8 * c) * 33 + n;
        v4u o; o.x = pk2(s[0 * 33], s[1 * 33]); o.y = pk2(s[2 * 33], s[3 * 33]); o.z = pk2(s[4 * 33], s[5 * 33]); o.w = pk2(s[6 * 33], s[7 * 33]);
        *(GAS v4u*)(WT + (size_t)(n0 + n) * K + k0 + 8 * c) = o; }
    LDS_WAIT(); asm volatile("" ::: "memory");
}
__device__ __forceinline__ void sincos_red(double a, float& s, float& c) {
    const double k = __builtin_rint(a * 0.63661977236758134308);
    double r = __builtin_fma(-k, 1.57079632679489655800e+00, a); r = __builtin_fma(-k, 6.12323399573676603587e-17, r);
    const int q = ((int)k) & 3; const float x = (float)r, x2 = x * x;
    const float sp = x + x * x2 * (-1.6666654611e-1f + x2 * (8.3321608736e-3f + x2 * (-1.9515295891e-4f)));
    const float cp = 1.f - 0.5f * x2 + x2 * x2 * (4.166664568298827e-2f + x2 * (-1.388731625493765e-3f + x2 * 2.443315711809948e-5f));
    s = (q == 0) ? sp : (q == 1) ? cp : (q == 2) ? -sp : -cp;
    c = (q == 0) ? cp : (q == 1) ? -sp : (q == 2) ? -cp : sp;
}
__device__ __forceinline__ void rms_store_bf16(const f32x4 (&v)[8], const float* g, bf16* orow, int lane) {
    float ss = 0.f;
#pragma unroll
    for (int j = 0; j < 8; ++j) ss += (v[j].x * v[j].x + v[j].y * v[j].y) + (v[j].z * v[j].z + v[j].w * v[j].w);
    const float r = 1.f / sqrtf(wave_sum(ss) * (1.f / DM) + EPS);
#pragma unroll
    for (int j = 0; j < 8; ++j) { const f32x4 gg = *(const GAS f32x4*)(g + 4 * (lane + 64 * j));
        v2u o; o.x = pk2(v[j].x * r * gg.x, v[j].y * r * gg.y); o.y = pk2(v[j].z * r * gg.z, v[j].w * r * gg.w);
        *(GAS v2u*)(orow + 4 * (lane + 64 * j)) = o; }
}

__device__ __forceinline__ void p0_prologue(Frame& F) {
    relaunder(F);
    LAS float* scr = (LAS float*)(F.lds + RING_OFF + F.wave * 16384);
    const int gw = F.vcu * NWAVES + F.wave, NGW = F.G * NWAVES;
    constexpr int I_IN = (DM / 64) * (ZW / 32), I_UP = (1024 / 64) * (DM / 32), I_SQ = (DM / 64) * (DM / 32), I_PLE = (PLE / 64) * (DM / 32);
    constexpr int PER_LAYER = I_IN + 3 * I_UP + 2 * I_SQ + I_PLE;
    for (int it = gw; it < DEPTH * PER_LAYER; it += NGW) {
        const int l = it / PER_LAYER; int r = it - l * PER_LAYER;
        if (r < I_IN) { p0_transpose_item<true>(F.w_in + (size_t)l * DM * INW, DM, INW, ZW, (bf16*)(F.ws + WS_WIN) + (size_t)l * ZW * DM, scr, r, F.lane); continue; } r -= I_IN;
        if (r < I_UP) { p0_transpose_item<false>(F.w_up0 + (size_t)l * 1024 * DM, 1024, DM, DM, (bf16*)(F.ws + WS_WUP) + (size_t)(l * 3 + 0) * DM * 1024, scr, r, F.lane); continue; } r -= I_UP;
        if (r < I_UP) { p0_transpose_item<false>(F.w_up1 + (size_t)l * 1024 * DM, 1024, DM, DM, (bf16*)(F.ws + WS_WUP) + (size_t)(l * 3 + 1) * DM * 1024, scr, r, F.lane); continue; } r -= I_UP;
        if (r < I_UP) { p0_transpose_item<false>(F.w_up2 + (size_t)l * 1024 * DM, 1024, DM, DM, (bf16*)(F.ws + WS_WUP) + (size_t)(l * 3 + 2) * DM * 1024, scr, r, F.lane); continue; } r -= I_UP;
        if (r < I_SQ) { p0_transpose_item<false>(F.w_out + (size_t)l * DM * DM, DM, DM, DM, (bf16*)(F.ws + WS_WOUT) + (size_t)l * DM * DM, scr, r, F.lane); continue; } r -= I_SQ;
        if (r < I_SQ) { p0_transpose_item<false>(F.w_pg + (size_t)l * DM * DM, DM, DM, DM, (bf16*)(F.ws + WS_WG) + (size_t)l * DM * DM, scr, r, F.lane); continue; } r -= I_SQ;
        p0_transpose_item<false>(F.w_ple + (size_t)l * PLE * DM, PLE, DM, DM, (bf16*)(F.ws + WS_WPLE) + (size_t)l * DM * PLE, scr, r, F.lane);
    }
    { const size_t n8 = (size_t)DEPTH * M * PLE / 8; bf16* pb = (bf16*)(F.ws + WS_PB);
      for (size_t i = (size_t)F.vcu * 512 + F.tid; i < n8; i += (size_t)F.G * 512) { const f32x4 a = *(const GAS f32x4*)(F.p + 8 * i), b = *(const GAS f32x4*)(F.p + 8 * i + 4);
          v4u o; o.x = pk2(a.x, a.y); o.y = pk2(a.z, a.w); o.z = pk2(b.x, b.y); o.w = pk2(b.z, b.w); *(GAS v4u*)(pb + 8 * i) = o; } }
    { float* rt = (float*)(F.ws + WS_ROPE);
      for (int i = F.vcu * 512 + F.tid; i < M * 32; i += F.G * 512) { const int m = i >> 5, f = i & 31;
          const double inv = exp(-(double)f * (9.210340371976184 / 32.0));
          float s, c; sincos_red((double)F.pos[m] * inv, s, c); rt[2 * i] = c; rt[2 * i + 1] = s; } }
    for (int m = gw; m < M; m += NGW) { f32x4 v[8];
#pragma unroll
        for (int j = 0; j < 8; ++j) v[j] = *(const GAS f32x4*)(F.x + (size_t)m * DM + 4 * (F.lane + 64 * j));
        rms_store_bf16(v, F.pre_g, (bf16*)(F.ws + WS_XB) + (size_t)m * DM, F.lane); }
}

__device__ __forceinline__ void phase_norm1(Frame& F, int l) {
    relaunder(F);
    const int gw = F.vcu * NWAVES + F.wave, NGW = F.G * NWAVES;
    const float* xin = (l == 0) ? F.x : F.out; const float* Y = (const float*)(F.ws + WS_YT); const float* g = F.post_g + l * DM; bf16* XB = (bf16*)(F.ws + WS_XB);
    for (int m = gw; m < M; m += NGW) { f32x4 y[8]; float ss = 0.f;
#pragma unroll
        for (int j = 0; j < 8; ++j) { y[j] = *(const GAS f32x4*)(Y + (size_t)m * DM + 4 * (F.lane + 64 * j)); ss += (y[j].x * y[j].x + y[j].y * y[j].y) + (y[j].z * y[j].z + y[j].w * y[j].w); }
        const float r = 1.f / sqrtf(wave_sum(ss) * (1.f / DM) + EPS);
#pragma unroll
        for (int j = 0; j < 8; ++j) { const int c = 4 * (F.lane + 64 * j); const f32x4 gg = *(const GAS f32x4*)(g + c); const f32x4 xv = *(const GAS f32x4*)(xin + (size_t)m * DM + c);
            const f32x4 o = xv + y[j] * r * gg; *(GAS f32x4*)(F.out + (size_t)m * DM + c) = o;
            v2u w; w.x = pk2(o.x, o.y); w.y = pk2(o.z, o.w); *(GAS v2u*)(XB + (size_t)m * DM + c) = w; } }
}
__device__ __forceinline__ void phase_norm2(Frame& F, int l) {
    relaunder(F);
    const int gw = F.vcu * NWAVES + F.wave, NGW = F.G * NWAVES;
    const float* T = (const float*)(F.ws + WS_YT); const float* g = F.ple_g + l * DM; bf16* XB = (bf16*)(F.ws + WS_XB);
    for (int m = gw; m < M; m += NGW) { f32x4 y[8]; float ss = 0.f;
#pragma unroll
        for (int j = 0; j < 8; ++j) { y[j] = *(const GAS f32x4*)(T + (size_t)m * DM + 4 * (F.lane + 64 * j)); ss += (y[j].x * y[j].x + y[j].y * y[j].y) + (y[j].z * y[j].z + y[j].w * y[j].w); }
        const float r = 1.f / sqrtf(wave_sum(ss) * (1.f / DM) + EPS);
#pragma unroll
        for (int j = 0; j < 8; ++j) { const int c = 4 * (F.lane + 64 * j); const f32x4 gg = *(const GAS f32x4*)(g + c); const f32x4 xv = *(const GAS f32x4*)(F.out + (size_t)m * DM + c);
            y[j] = xv + y[j] * r * gg; *(GAS f32x4*)(F.out + (size_t)m * DM + c) = y[j]; }
        if (l < DEPTH - 1) rms_store_bf16(y, F.pre_g + (l + 1) * DM, XB + (size_t)m * DM, F.lane); }
}

__device__ __forceinline__ void phase_conv(Frame& F, int l) {
    relaunder(F);
    const bf16* Z = (const bf16*)(F.ws + WS_Z); bf16* YC = (bf16*)(F.ws + WS_YC);
    const int cg = F.tid & 127, ts = F.tid >> 7, c0 = cg * 8;
    float w0[8], w1[8], w2[8];
#pragma unroll
    for (int j = 0; j < 8; ++j) { w0[j] = F.conv_w[(l * 3 + 0) * CCH + c0 + j]; w1[j] = F.conv_w[(l * 3 + 1) * CCH + c0 + j]; w2[j] = F.conv_w[(l * 3 + 2) * CCH + c0 + j]; }
    for (int u = F.vcu; u < M / 64; u += F.G) {
        const int t0 = u * 64 + ts * 16;
        float vm2[8], vm1[8];
        if ((t0 & (SEQ - 1)) == 0) {
#pragma unroll
            for (int j = 0; j < 8; ++j) { vm2[j] = 0.f; vm1[j] = 0.f; }
        } else { float a[8], b[8];
            unpack8(*(const GAS v4u*)(Z + (size_t)(t0 - 2) * ZW + ZC_CC + c0), a); unpack8(*(const GAS v4u*)(Z + (size_t)(t0 - 2) * ZW + ZC_CX + c0), b);
#pragma unroll
            for (int j = 0; j < 8; ++j) vm2[j] = a[j] * b[j];
            unpack8(*(const GAS v4u*)(Z + (size_t)(t0 - 1) * ZW + ZC_CC + c0), a); unpack8(*(const GAS v4u*)(Z + (size_t)(t0 - 1) * ZW + ZC_CX + c0), b);
#pragma unroll
            for (int j = 0; j < 8; ++j) vm1[j] = a[j] * b[j]; }
#pragma unroll 4
        for (int i = 0; i < 16; ++i) { const size_t zr = (size_t)(t0 + i) * ZW; float a[8], b[8], cb[8], gg[8], o[8];
            unpack8(*(const GAS v4u*)(Z + zr + ZC_CC + c0), a); unpack8(*(const GAS v4u*)(Z + zr + ZC_CX + c0), b);
            unpack8(*(const GAS v4u*)(Z + zr + ZC_CB + c0), cb); unpack8(*(const GAS v4u*)(Z + zr + ZC_CG + c0), gg);
#pragma unroll
            for (int j = 0; j < 8; ++j) { const float v = a[j] * b[j]; const float y = w0[j] * vm2[j] + w1[j] * vm1[j] + w2[j] * v; o[j] = cb[j] * y * siluf_(gg[j]); vm2[j] = vm1[j]; vm1[j] = v; }
            *(GAS v4u*)(YC + (size_t)(t0 + i) * CCH + c0) = pack8(o); }
    }
}

__device__ __forceinline__ void phase_attn_naive(Frame& F, int l) {
    relaunder(F);
    const bf16* Z = (const bf16*)(F.ws + WS_Z); bf16* YA = (bf16*)(F.ws + WS_YA); const float* rope = (const float*)(F.ws + WS_ROPE);
    const int gw = F.vcu * NWAVES + F.wave, NGW = F.G * NWAVES, d = F.lane, f = d & 31;
    for (int task = gw; task < M * AQH; task += NGW) {
        const int m = task >> 4, hq = task & 15, kvh = hq >> 2, s = m & (SEQ - 1);
        float q = bf2f(Z[(size_t)m * ZW + ZC_AQ + hq * 64 + d]); { const float pq = __shfl_xor(q, 32); const float c = rope[2 * (m * 32 + f)], sn = rope[2 * (m * 32 + f) + 1];
            q = (d < 32 ? q * c - pq * sn : q * c + pq * sn) * 0.125f; }
        float sc0 = -INFINITY, sc1 = -INFINITY;
        for (int kidx = 0; kidx < AWIN; ++kidx) { if (s - 127 + kidx < 0) continue; const int mk = m - 127 + kidx;
            float k = bf2f(Z[(size_t)mk * ZW + ZC_AK + kvh * 64 + d]); const float pk = __shfl_xor(k, 32); const float c = rope[2 * (mk * 32 + f)], sn = rope[2 * (mk * 32 + f) + 1];
            k = d < 32 ? k * c - pk * sn : k * c + pk * sn;
            const float sc = wave_sum(q * k);
            if (d == (kidx & 63)) { if (kidx < 64) sc0 = sc; else sc1 = sc; } }
        const float sink = F.sinks[l * AQH + hq];
        const float mx = fmaxf(wave_max(fmaxf(sc0, sc1)), sink);
        const float p0 = __expf(sc0 - mx), p1 = __expf(sc1 - mx);
        const float den = wave_sum(p0 + p1) + __expf(sink - mx);
        float o = 0.f;
        for (int kidx = 0; kidx < AWIN; ++kidx) { if (s - 127 + kidx < 0) continue; const int mk = m - 127 + kidx;
            const float pp = __shfl(kidx < 64 ? p0 : p1, kidx & 63);
            o += pp * bf2f(Z[(size_t)mk * ZW + ZC_AV + kvh * 64 + d]); }
        o = o / den * siluf_(bf2f(Z[(size_t)m * ZW + ZC_AG + hq * 64 + d]));
        YA[(size_t)m * AQW + hq * 64 + d] = (bf16)f2bf(o);
    }
}


typedef short s16x4 __attribute__((ext_vector_type(4)));
typedef short v4i16_t __attribute__((ext_vector_type(4)));
__device__ __forceinline__ s16x4 vtr(const LAS unsigned char* p) { return __builtin_bit_cast(s16x4, __builtin_amdgcn_ds_read_tr16_b64_v4i16((LAS v4i16_t*)p)); }
__device__ __forceinline__ bf16x8 cat4(s16x4 a, s16x4 b) { return (bf16x8){a[0], a[1], a[2], a[3], b[0], b[1], b[2], b[3]}; }
__device__ __forceinline__ int tr_lane_off(int lane, int rs) { return (8 * (lane >> 5) + ((lane & 15) >> 2)) * rs + (16 * ((lane >> 4) & 1) + 4 * (lane & 3)) * 2; }
__device__ __forceinline__ bf16x8 tr_frag(const LAS unsigned char* trb, int k0, int c0, int rs) { return cat4(vtr(trb + k0 * rs + c0 * 2), vtr(trb + (k0 + 4) * rs + c0 * 2)); }
#define MFMA32(a, b, c) __builtin_amdgcn_mfma_f32_32x32x16_bf16((a), (b), (c), 0, 0, 0)

constexpr int ARS = 144;
constexpr int LA_K = 0, LA_V = 256 * ARS;
__device__ __forceinline__ void phase_attn(Frame& F, int l) {
    relaunder(F);
    const bf16* Z = (const bf16*)(F.ws + WS_Z); bf16* YA = (bf16*)(F.ws + WS_YA); const float* rope = (const float*)(F.ws + WS_ROPE);
    LAS unsigned char* ring = F.lds + RING_OFF;
    const int lane = F.lane, c = lane & 31, hh = lane >> 5;
    for (int u = F.vcu; u < NB * 32 * AKVH; u += F.G) {
        const int b = u >> 7, nb = (u >> 2) & 31, kvh = u & 3; const int tk0 = b * SEQ + nb * 128 - 128;
#pragma unroll
        for (int i = 0; i < 2; ++i) { const int task = F.tid + 512 * i, kk = task >> 2, pc = task & 3; const bool ok = nb > 0 || kk >= 128; const int tk = tk0 + kk;
            float lo[8], hi[8], ol[8], oh[8];
            if (ok) { const bf16* kp = Z + (size_t)tk * ZW + ZC_AK + kvh * 64 + 8 * pc; unpack8(*(const GAS v4u*)kp, lo); unpack8(*(const GAS v4u*)(kp + 32), hi);
                const float* rp = rope + ((size_t)tk * 32 + 8 * pc) * 2;
#pragma unroll
                for (int q4 = 0; q4 < 4; ++q4) { const f32x4 cs = *(const GAS f32x4*)(rp + 4 * q4);
                    ol[2 * q4] = lo[2 * q4] * cs.x - hi[2 * q4] * cs.y; oh[2 * q4] = hi[2 * q4] * cs.x + lo[2 * q4] * cs.y;
                    ol[2 * q4 + 1] = lo[2 * q4 + 1] * cs.z - hi[2 * q4 + 1] * cs.w; oh[2 * q4 + 1] = hi[2 * q4 + 1] * cs.z + lo[2 * q4 + 1] * cs.w; } }
            else {
#pragma unroll
                for (int j = 0; j < 8; ++j) { ol[j] = 0.f; oh[j] = 0.f; } }
            *(LAS v4u*)(ring + LA_K + kk * ARS + 16 * pc) = pack8(ol); *(LAS v4u*)(ring + LA_K + kk * ARS + 64 + 16 * pc) = pack8(oh); }
#pragma unroll
        for (int i = 0; i < 4; ++i) { const int ch = F.tid + 512 * i, kk = ch >> 3, cc = ch & 7; const bool ok = nb > 0 || kk >= 128;
            v4u v = (v4u){0u, 0u, 0u, 0u}; if (ok) v = *(const GAS v4u*)(Z + (size_t)(tk0 + kk) * ZW + ZC_AV + kvh * 64 + 8 * cc);
            *(LAS v4u*)(ring + LA_V + kk * ARS + 16 * cc) = v; }
        __syncthreads();
        const LAS unsigned char* vtrb = ring + LA_V + tr_lane_off(lane, ARS);
#pragma unroll 1
        for (int i = 0; i < 2; ++i) {
            const int task = F.wave * 2 + i, hq = kvh * 4 + (task >> 2), qg = task & 3, q0 = qg * 32, qi = q0 + c; const int tq = b * SEQ + nb * 128 + qi;
            bf16x8 qf[4];
            { const bf16* qp = Z + (size_t)tq * ZW + ZC_AQ + hq * 64 + 8 * hh;
#pragma unroll
              for (int k2 = 0; k2 < 2; ++k2) { float lo[8], hi[8], ol[8], oh[8]; unpack8(*(const GAS v4u*)(qp + 16 * k2), lo); unpack8(*(const GAS v4u*)(qp + 16 * k2 + 32), hi);
                  const float* rp = rope + ((size_t)tq * 32 + 16 * k2 + 8 * hh) * 2;
#pragma unroll
                  for (int q4 = 0; q4 < 4; ++q4) { const f32x4 cs = *(const GAS f32x4*)(rp + 4 * q4);
                      ol[2 * q4] = (lo[2 * q4] * cs.x - hi[2 * q4] * cs.y) * 0.125f; oh[2 * q4] = (hi[2 * q4] * cs.x + lo[2 * q4] * cs.y) * 0.125f;
                      ol[2 * q4 + 1] = (lo[2 * q4 + 1] * cs.z - hi[2 * q4 + 1] * cs.w) * 0.125f; oh[2 * q4 + 1] = (hi[2 * q4 + 1] * cs.z + lo[2 * q4 + 1] * cs.w) * 0.125f; }
                  qf[k2] = __builtin_bit_cast(bf16x8, pack8(ol)); qf[k2 + 2] = __builtin_bit_cast(bf16x8, pack8(oh)); } }
            f32x16 st[5];
#pragma unroll
            for (int t = 0; t < 5; ++t) {
#pragma unroll
                for (int r = 0; r < 16; ++r) st[t][r] = 0.f;
#pragma unroll
                for (int ks = 0; ks < 4; ++ks) { const bf16x8 kf = *(const LAS bf16x8*)(ring + LA_K + (32 * (qg + t) + c) * ARS + (16 * ks + 8 * hh) * 2);
                    st[t] = MFMA32(kf, qf[ks], st[t]); } }
            const float sink = F.sinks[l * AQH + hq]; float mx = sink;
#pragma unroll
            for (int t = 0; t < 5; ++t)
#pragma unroll
                for (int r = 0; r < 16; ++r) { const int kk = 32 * (qg + t) + (r & 3) + 8 * (r >> 2) + 4 * hh;
                    const bool ok = (kk > qi) && (kk <= qi + 128) && (nb > 0 || kk >= 128);
                    st[t][r] = ok ? st[t][r] : -INFINITY; mx = fmaxf(mx, st[t][r]); }
            mx = fmaxf(mx, __shfl_xor(mx, 32));
            float sum = 0.f;
#pragma unroll
            for (int t = 0; t < 5; ++t)
#pragma unroll
                for (int r = 0; r < 16; ++r) { const float p = __expf(st[t][r] - mx); st[t][r] = p; sum += p; }
            sum += __shfl_xor(sum, 32); sum += __expf(sink - mx);
            const float rinv = 1.f / sum;
            bf16x8 pf[5][2];
#pragma unroll
            for (int t = 0; t < 5; ++t)
#pragma unroll
                for (int s2 = 0; s2 < 2; ++s2) { v4u w; w.x = pk2(st[t][8 * s2], st[t][8 * s2 + 1]); w.y = pk2(st[t][8 * s2 + 2], st[t][8 * s2 + 3]); w.z = pk2(st[t][8 * s2 + 4], st[t][8 * s2 + 5]); w.w = pk2(st[t][8 * s2 + 6], st[t][8 * s2 + 7]);
                    pf[t][s2] = __builtin_bit_cast(bf16x8, w); }
#pragma unroll
            for (int dt = 0; dt < 2; ++dt) { f32x16 o;
#pragma unroll
                for (int r = 0; r < 16; ++r) o[r] = 0.f;
#pragma unroll
                for (int t = 0; t < 5; ++t)
#pragma unroll
                    for (int s2 = 0; s2 < 2; ++s2) { const int kb = 32 * (qg + t) + 16 * s2;
                        const bf16x8 vf = cat4(vtr(vtrb + (kb - 4 * hh) * ARS + (32 * dt) * 2), vtr(vtrb + (kb + 8 - 4 * hh) * ARS + (32 * dt) * 2));
                        o = MFMA32(vf, pf[t][s2], o); }
#pragma unroll
                for (int g4 = 0; g4 < 4; ++g4) { const int d = 32 * dt + 8 * g4 + 4 * hh; const v2u gv = *(const GAS v2u*)(Z + (size_t)tq * ZW + ZC_AG + hq * 64 + d);
                    const float g0 = siluf_(bflo(gv.x)), g1 = siluf_(bfhi(gv.x)), g2 = siluf_(bflo(gv.y)), g3 = siluf_(bfhi(gv.y));
                    v2u w; w.x = pk2(o[4 * g4] * rinv * g0, o[4 * g4 + 1] * rinv * g1); w.y = pk2(o[4 * g4 + 2] * rinv * g2, o[4 * g4 + 3] * rinv * g3);
                    *(GAS v2u*)(YA + (size_t)tq * AQW + hq * 64 + d) = w; } }
        }
        __syncthreads();
    }
}

constexpr int RS128 = 272, RS64 = 144, RSH = 528;
constexpr int L_Q = 0, L_K = 17408, L_V = 34816, L_CP = 52224, L_SW = 87040, L_HB = 96256;
constexpr int S_W = 0, S_ROWT = 256, S_COLT = 512, S_WQ = 768, S_EM = 1024, S_DEN = 1280, S_NP = 1536;
__device__ __forceinline__ float logsigmoidf_(float x) { return x >= 0.f ? -log1pf(expf(-x)) : x - log1pf(expf(x)); }

__device__ __forceinline__ void chunk_gates(Frame& F, int l, const bf16* Z, int m0, int h, float& bc, float& li) {
    const float fpre = bf2f(Z[(size_t)(m0 + F.lane) * ZW + ZC_MF + h]) + F.b_fg[l * MH + h];
    li = bf2f(Z[(size_t)(m0 + F.lane) * ZW + ZC_MI + h]) + F.b_ig[l * MH + h];
    bc = logsigmoidf_(fpre);
#pragma unroll
    for (int o = 1; o < 64; o <<= 1) { const float t = __shfl_up(bc, o); if (F.lane >= o) bc += t; }
}

__device__ __forceinline__ void phase_m1(Frame& F, int l) {
    relaunder(F);
    const bf16* Z = (const bf16*)(F.ws + WS_Z); float* CST = (float*)(F.ws + WS_CST); float* NST = (float*)(F.ws + WS_NST); float* SCL = (float*)(F.ws + WS_SCL);
    LAS unsigned char* ring = F.lds + RING_OFF; LAS float* sw = (LAS float*)(F.lds + SCAL_OFF + S_W);
    for (int u = F.vcu; u < NB * MH * NCH; u += F.G) {
        const int bh = u >> 6, c = u & 63, b = bh >> 3, h = bh & 7, m0 = b * SEQ + c * LCH;
        if (F.wave == 0) { float bc, li; chunk_gates(F, l, Z, m0, h, bc, li);
            const float blast = __shfl(bc, 63); const float g = blast - bc + li; const float gmax = wave_max(g);
            sw[F.lane] = __expf(g - gmax);
            if (F.lane == 0) { SCL[u] = gmax; SCL[2048 + u] = blast; } }
        __syncthreads();
#pragma unroll
        for (int i = 0; i < 2; ++i) { const int ch = F.tid + 512 * i, r = ch >> 4, cc = ch & 15; const size_t zr = (size_t)(m0 + r) * ZW + h * MHD + cc * 8;
            float v[8]; unpack8(*(const GAS v4u*)(Z + zr + ZC_MV), v); const float w = sw[r];
#pragma unroll
            for (int j = 0; j < 8; ++j) v[j] *= w;
            *(LAS v4u*)(ring + L_Q + r * RS128 + cc * 16) = pack8(v);
            *(LAS v4u*)(ring + L_K + r * RS128 + cc * 16) = *(const GAS v4u*)(Z + zr + ZC_MK); }
        __syncthreads();
        if (F.tid < 128) { float n = 0.f;
            for (int r = 0; r < 64; ++r) n += sw[r] * bf2f(*(LAS bf16*)(ring + L_K + r * RS128 + F.tid * 2));
            NST[(size_t)u * 128 + F.tid] = n; }
#if NAIVE_MLSTM
        {
            const int d = F.tid >> 2, e0 = (F.tid & 3) * 32; float acc[32];
#pragma unroll
            for (int j = 0; j < 32; ++j) acc[j] = 0.f;
            for (int r = 0; r < 64; ++r) { const float vw = bf2f(*(LAS bf16*)(ring + L_Q + r * RS128 + d * 2));
#pragma unroll
                for (int q = 0; q < 4; ++q) { float kk[8]; unpack8(*(LAS v4u*)(ring + L_K + r * RS128 + (e0 + 8 * q) * 2), kk);
#pragma unroll
                    for (int j = 0; j < 8; ++j) acc[8 * q + j] += vw * kk[j]; } }
            float* cp = CST + (size_t)u * 16384 + d * 128 + e0;
#pragma unroll
            for (int q = 0; q < 8; ++q) *(GAS f32x4*)(cp + 4 * q) = (f32x4){acc[4 * q], acc[4 * q + 1], acc[4 * q + 2], acc[4 * q + 3]}; }
#else
        {
            const int d0 = 32 * (F.wave >> 1), e0 = 64 * (F.wave & 1); const int tro = tr_lane_off(F.lane, RS128);
            f32x16 a0, a1;
#pragma unroll
            for (int r = 0; r < 16; ++r) { a0[r] = 0.f; a1[r] = 0.f; }
#pragma unroll
            for (int ks = 0; ks < 4; ++ks) { const bf16x8 af = tr_frag(ring + L_Q + tro, 16 * ks, d0, RS128);
                const bf16x8 b0 = tr_frag(ring + L_K + tro, 16 * ks, e0, RS128), b1 = tr_frag(ring + L_K + tro, 16 * ks, e0 + 32, RS128);
                a0 = MFMA32(af, b0, a0); a1 = MFMA32(af, b1, a1); }
            float* cp = CST + (size_t)u * 16384 + (size_t)(d0 + 4 * (F.lane >> 5)) * 128 + e0 + (F.lane & 31);
#pragma unroll
            for (int r = 0; r < 16; ++r) { const int dr = (r & 3) + 8 * (r >> 2); cp[dr * 128] = a0[r]; cp[dr * 128 + 32] = a1[r]; } }
#endif
        __syncthreads();
    }
}
__device__ __forceinline__ void phase_m2(Frame& F) {
    relaunder(F);
    float* CST = (float*)(F.ws + WS_CST); float* NST = (float*)(F.ws + WS_NST); float* SCL = (float*)(F.ws + WS_SCL);
    for (int gid = F.vcu * 512 + F.tid; gid < 32 * 4096 + 32 * 32; gid += F.G * 512) {
        const bool isn = gid >= 32 * 4096; const int g2 = isn ? gid - 32 * 4096 : gid;
        const int bh = isn ? (g2 >> 5) : (g2 >> 12), idx = isn ? (g2 & 31) : (g2 & 4095);
        float* base = isn ? NST + (size_t)bh * 64 * 128 + idx * 4 : CST + (size_t)bh * 64 * 16384 + idx * 4; const size_t cs = isn ? 128 : 16384;
        float mrun = 0.f; f32x4 st = (f32x4){0.f, 0.f, 0.f, 0.f};
        for (int c0 = 0; c0 < 64; c0 += 8) { f32x4 tmp[8];
#pragma unroll
            for (int j = 0; j < 8; ++j) tmp[j] = *(const GAS f32x4*)(base + (size_t)(c0 + j) * cs);
#pragma unroll
            for (int j = 0; j < 8; ++j) { const float gm = SCL[bh * 64 + c0 + j], bl = SCL[2048 + bh * 64 + c0 + j];
                const float mnew = fmaxf(bl + mrun, gm), a = __expf(bl + mrun - mnew), cc = __expf(gm - mnew);
                *(GAS f32x4*)(base + (size_t)(c0 + j) * cs) = st;
                if (!isn && idx == 0) SCL[4096 + bh * 64 + c0 + j] = mrun;
                st = st * a + tmp[j] * cc; mrun = mnew; } }
    }
}
__device__ __forceinline__ void phase_m3(Frame& F, int l) {
    relaunder(F);
    const bf16* Z = (const bf16*)(F.ws + WS_Z); const float* CST = (const float*)(F.ws + WS_CST); const float* NST = (const float*)(F.ws + WS_NST); const float* SCL = (const float*)(F.ws + WS_SCL);
    bf16* YM = (bf16*)(F.ws + WS_YM);
    LAS unsigned char* ring = F.lds + RING_OFF; LAS unsigned char* scal = F.lds + SCAL_OFF;
    LAS float* s_rowt = (LAS float*)(scal + S_ROWT); LAS float* s_colt = (LAS float*)(scal + S_COLT); LAS float* s_wq = (LAS float*)(scal + S_WQ);
    LAS float* s_em = (LAS float*)(scal + S_EM); LAS float* s_den = (LAS float*)(scal + S_DEN); LAS float* s_np = (LAS float*)(scal + S_NP);
    const float scale = 0.08838834764831845f;
    for (int u = F.vcu; u < NB * MH * NCH; u += F.G) {
        const int bh = u >> 6, c = u & 63, b = bh >> 3, h = bh & 7, m0 = b * SEQ + c * LCH;
        if (F.wave == 0) { float bc, li; chunk_gates(F, l, Z, m0, h, bc, li);
            const float uu = li - bc; float pm = uu;
#pragma unroll
            for (int o = 1; o < 64; o <<= 1) { const float t = __shfl_up(pm, o); if (F.lane >= o) pm = fmaxf(pm, t); }
            const float mp = SCL[4096 + u], inter = bc + mp, mm = fmaxf(inter, bc + pm);
            s_rowt[F.lane] = bc - mm; s_colt[F.lane] = uu; s_wq[F.lane] = __expf(inter - mm) * scale; s_em[F.lane] = __expf(-mm); }
        if (F.wave == 1) { s_np[F.lane] = NST[(size_t)u * 128 + F.lane]; s_np[64 + F.lane] = NST[(size_t)u * 128 + 64 + F.lane]; }
#pragma unroll
        for (int i = 0; i < 2; ++i) { const int ch = F.tid + 512 * i, r = ch >> 4, cc = ch & 15; const size_t zr = (size_t)(m0 + r) * ZW + h * MHD + cc * 8;
            *(LAS v4u*)(ring + L_Q + r * RS128 + cc * 16) = *(const GAS v4u*)(Z + zr + ZC_MQ);
            *(LAS v4u*)(ring + L_K + r * RS128 + cc * 16) = *(const GAS v4u*)(Z + zr + ZC_MK);
            *(LAS v4u*)(ring + L_V + r * RS128 + cc * 16) = *(const GAS v4u*)(Z + zr + ZC_MV); }
#pragma unroll
        for (int i = 0; i < 4; ++i) { const int ch = F.tid + 512 * i, r = ch >> 4, cc = ch & 15; const float* cp = CST + (size_t)u * 16384 + r * 128 + cc * 8;
            const f32x4 a = *(const GAS f32x4*)cp, bq = *(const GAS f32x4*)(cp + 4);
            v4u o; o.x = pk2(a.x, a.y); o.y = pk2(a.z, a.w); o.z = pk2(bq.x, bq.y); o.w = pk2(bq.z, bq.w);
            *(LAS v4u*)(ring + L_CP + r * RS128 + cc * 16) = o; }
        __syncthreads();
#if NAIVE_MLSTM
        {
            const int li = F.tid >> 3, s0 = (F.tid & 7) * 8; float sv[8];
#pragma unroll
            for (int j = 0; j < 8; ++j) sv[j] = 0.f;
            if (s0 <= li) {
                for (int cc = 0; cc < 16; ++cc) { float qv[8]; unpack8(*(LAS v4u*)(ring + L_Q + li * RS128 + cc * 16), qv);
#pragma unroll
                    for (int j = 0; j < 8; ++j) { float kv[8]; unpack8(*(LAS v4u*)(ring + L_K + (s0 + j) * RS128 + cc * 16), kv);
#pragma unroll
                        for (int e = 0; e < 8; ++e) sv[j] += qv[e] * kv[e]; } }
                const float rt = s_rowt[li];
#pragma unroll
                for (int j = 0; j < 8; ++j) sv[j] = (s0 + j <= li) ? sv[j] * scale * __expf(rt + s_colt[s0 + j]) : 0.f; }
            *(LAS v4u*)(ring + L_SW + li * RS64 + s0 * 2) = pack8(sv); }
        __syncthreads();
        {
            const int li = F.tid >> 3, sub = F.tid & 7, d0 = sub * 16; float a1[16], a2[16];
#pragma unroll
            for (int j = 0; j < 16; ++j) { a1[j] = 0.f; a2[j] = 0.f; }
            float dsum = 0.f;
            for (int s8 = 0; s8 < 8; ++s8) { float sw8[8]; unpack8(*(LAS v4u*)(ring + L_SW + li * RS64 + s8 * 16), sw8);
                if (s8 == sub) {
#pragma unroll
                    for (int j = 0; j < 8; ++j) dsum += sw8[j]; }
#pragma unroll
                for (int j = 0; j < 8; ++j) { float v0[8], v1[8]; unpack8(*(LAS v4u*)(ring + L_V + (s8 * 8 + j) * RS128 + d0 * 2), v0); unpack8(*(LAS v4u*)(ring + L_V + (s8 * 8 + j) * RS128 + d0 * 2 + 16), v1);
#pragma unroll
                    for (int e = 0; e < 8; ++e) { a1[e] += sw8[j] * v0[e]; a1[8 + e] += sw8[j] * v1[e]; } } }
            float qn = 0.f;
            for (int cc = 0; cc < 16; ++cc) { float qv[8]; unpack8(*(LAS v4u*)(ring + L_Q + li * RS128 + cc * 16), qv);
                if ((cc >> 1) == sub) {
#pragma unroll
                    for (int e = 0; e < 8; ++e) qn += qv[e] * s_np[cc * 8 + e]; }
#pragma unroll
                for (int j = 0; j < 16; ++j) { float cv[8]; unpack8(*(LAS v4u*)(ring + L_CP + (d0 + j) * RS128 + cc * 16), cv);
#pragma unroll
                    for (int e = 0; e < 8; ++e) a2[j] += qv[e] * cv[e]; } }
            const float wq = s_wq[li];
            float den = dsum + wq * qn; den += __shfl_xor(den, 1); den += __shfl_xor(den, 2); den += __shfl_xor(den, 4);
            const float dn = fmaxf(fabsf(den), s_em[li]);
            LAS float* hb = (LAS float*)(ring + L_HB + li * RSH) + d0;
#pragma unroll
            for (int j = 0; j < 16; ++j) hb[j] = (a1[j] + wq * a2[j]) / dn;
        }
        __syncthreads();
#else
        if (F.wave < 4) {
            const int l0 = 32 * (F.wave >> 1), s0 = 32 * (F.wave & 1), c = F.lane & 31, hh = F.lane >> 5; f32x16 a;
#pragma unroll
            for (int r = 0; r < 16; ++r) a[r] = 0.f;
            if (s0 <= l0) {
#pragma unroll
                for (int ks = 0; ks < 8; ++ks) { const bf16x8 qf = *(const LAS bf16x8*)(ring + L_Q + (l0 + c) * RS128 + (16 * ks + 8 * hh) * 2), kf = *(const LAS bf16x8*)(ring + L_K + (s0 + c) * RS128 + (16 * ks + 8 * hh) * 2);
                    a = MFMA32(qf, kf, a); } }
            const int sc = s0 + c; const float ct = s_colt[sc];
#pragma unroll
            for (int r = 0; r < 16; ++r) { const int lr = l0 + (r & 3) + 8 * (r >> 2) + 4 * hh; const float v = (sc <= lr) ? a[r] * scale * __expf(s_rowt[lr] + ct) : 0.f;
                *(LAS bf16*)(ring + L_SW + lr * RS64 + sc * 2) = (bf16)f2bf(v); } }
        __syncthreads();
        {
            const int li = F.tid >> 3, sub = F.tid & 7; float sw8[8], qv[8], qv2[8]; unpack8(*(LAS v4u*)(ring + L_SW + li * RS64 + sub * 16), sw8);
            unpack8(*(LAS v4u*)(ring + L_Q + li * RS128 + sub * 32), qv); unpack8(*(LAS v4u*)(ring + L_Q + li * RS128 + sub * 32 + 16), qv2);
            float dsum = 0.f, qn = 0.f;
#pragma unroll
            for (int j = 0; j < 8; ++j) { dsum += sw8[j]; qn += qv[j] * s_np[sub * 16 + j] + qv2[j] * s_np[sub * 16 + 8 + j]; }
            float den = dsum + s_wq[li] * qn; den += __shfl_xor(den, 1); den += __shfl_xor(den, 2); den += __shfl_xor(den, 4);
            if (sub == 0) s_den[li] = fmaxf(fabsf(den), s_em[li]); }
        {
            const int l0 = 32 * (F.wave >> 2), d0 = 32 * (F.wave & 3), c = F.lane & 31, hh = F.lane >> 5; const int tro = tr_lane_off(F.lane, RS128);
            f32x16 a1, a2;
#pragma unroll
            for (int r = 0; r < 16; ++r) { a1[r] = 0.f; a2[r] = 0.f; }
#pragma unroll
            for (int ks = 0; ks < 4; ++ks) { const bf16x8 sf = *(const LAS bf16x8*)(ring + L_SW + (l0 + c) * RS64 + (16 * ks + 8 * hh) * 2); const bf16x8 vf = tr_frag(ring + L_V + tro, 16 * ks, d0, RS128);
                a1 = MFMA32(sf, vf, a1); }
#pragma unroll
            for (int ks = 0; ks < 8; ++ks) { const bf16x8 qf = *(const LAS bf16x8*)(ring + L_Q + (l0 + c) * RS128 + (16 * ks + 8 * hh) * 2), cf = *(const LAS bf16x8*)(ring + L_CP + (d0 + c) * RS128 + (16 * ks + 8 * hh) * 2);
                a2 = MFMA32(qf, cf, a2); }
#pragma unroll
            for (int r = 0; r < 16; ++r) { const int lr = l0 + (r & 3) + 8 * (r >> 2) + 4 * hh; *((LAS float*)(ring + L_HB + lr * RSH) + d0 + c) = a1[r] + s_wq[lr] * a2[r]; } }
        __syncthreads();
#endif
        {
            const int li = F.tid >> 3, d0 = (F.tid & 7) * 16; const LAS float* hb = (const LAS float*)(ring + L_HB + li * RSH) + d0; float hv[16]; float ss = 0.f;
#if NAIVE_MLSTM
            const float dinv = 1.f;
#else
            const float dinv = 1.f / s_den[li];
#endif
#pragma unroll
            for (int j = 0; j < 16; ++j) { hv[j] = hb[j] * dinv; ss += hv[j] * hv[j]; }
            ss += __shfl_xor(ss, 1); ss += __shfl_xor(ss, 2); ss += __shfl_xor(ss, 4);
            const float r = 1.f / sqrtf(ss * (1.f / MHD) + EPS);
            const size_t zr = (size_t)(m0 + li) * ZW + h * MHD + d0; float mo[16], mg[16], o[16];
            unpack8(*(const GAS v4u*)(Z + zr + ZC_MO), mo); unpack8(*(const GAS v4u*)(Z + zr + ZC_MO + 8), mo + 8);
            unpack8(*(const GAS v4u*)(Z + zr + ZC_MG), mg); unpack8(*(const GAS v4u*)(Z + zr + ZC_MG + 8), mg + 8);
#pragma unroll
            for (int j = 0; j < 16; ++j) o[j] = hv[j] * r * F.m_norm[l * MW + h * MHD + d0 + j] * sigmoidf_(mo[j]) * siluf_(mg[j]);
            bf16* yp = YM + (size_t)(m0 + li) * MW + h * MHD + d0;
            *(GAS v4u*)yp = pack8(o); *(GAS v4u*)(yp + 8) = pack8(o + 8); }
        __syncthreads();
    }
}

struct Args { const void* in[18]; float* out; unsigned char* ws; int ph_lo, ph_hi; };
constexpr int PH_PER_LAYER = 9, NPH = 1 + DEPTH * PH_PER_LAYER;

__global__ void __launch_bounds__(NWAVES * 64, 2) fwd(Args args) {
    extern __shared__ __attribute__((aligned(16))) unsigned char lds[];
    Frame F;
    F.lds = (LAS unsigned char*)lds;
    F.tid = threadIdx.x; F.lane = F.tid & 63; F.wave = __builtin_amdgcn_readfirstlane(F.tid >> 6);
    F.G = gridDim.x; { const int bx = blockIdx.x; F.vcu = (F.G % 8 == 0) ? (bx % 8) * (F.G / 8) + bx / 8 : bx; }
    F.ws = args.ws; F.out = args.out;
    F.x = (const float*)args.in[0]; F.p = (const float*)args.in[1]; F.pos = (const int*)args.in[2]; F.w_in = (const float*)args.in[3]; F.conv_w = (const float*)args.in[4];
    F.b_ig = (const float*)args.in[5]; F.b_fg = (const float*)args.in[6]; F.m_norm = (const float*)args.in[7]; F.sinks = (const float*)args.in[8];
    F.w_up0 = (const float*)args.in[9]; F.w_up1 = (const float*)args.in[10]; F.w_up2 = (const float*)args.in[11]; F.w_out = (const float*)args.in[12];
    F.pre_g = (const float*)args.in[13]; F.post_g = (const float*)args.in[14]; F.w_ple = (const float*)args.in[15]; F.w_pg = (const float*)args.in[16]; F.ple_g = (const float*)args.in[17];
    volatile LAS unsigned* MISC = (volatile LAS unsigned*)(F.lds + MISC_OFF);
    for (int u = F.tid; u < (LDS_BYTES - MISC_OFF) / 4; u += NWAVES * 64) ((LAS unsigned*)(F.lds + MISC_OFF))[u] = 0u;
    __syncthreads();
    unsigned* ctl = (unsigned*)(F.ws + WS_CTL);
    XcdBarrier bar; bar.bar = ctl + CW_BAR; bar.x = 0; bar.st = nullptr;
#if MK_ONE_LAUNCH
    bar = xcd_barrier_post(ctl + CW_BAR, MISC + 8);
#define GRID_BAR() xcd_barrier(bar)
#else
#define GRID_BAR() do { if (F.tid == 0) __hip_atomic_store((gu32*)(ctl + CW_TMO), 0xBADBA0u, RLX_AGENT); } while (0)
#endif
    const int lo = args.ph_lo, hi = args.ph_hi;
#define IN(k) (lo <= (k) && (k) < hi)
#define BOTH(k) (IN(k) && IN((k) + 1))

    if (IN(0)) { p0_prologue(F); if (BOTH(0)) GRID_BAR(); }

    for (int l = 0; l < DEPTH; ++l) {
        const int pb = 1 + l * PH_PER_LAYER;
        const bf16* Win_t = (const bf16*)(F.ws + WS_WIN) + (size_t)l * ZW * DM;
        if (IN(pb + 0)) {
            pg8::Gemm g{(const bf16*)(F.ws + WS_XB), Win_t, 0, 0, M, ZW, DM, 1};
            pg8::StaticOrder S; S.init(M, ZW, F.G, (int)blockIdx.x, 1);
            pg8::EpiBf16 E{(bf16*)(F.ws + WS_Z), ZW};
            pg8::gemm_phase<pg8::EpiBf16>(F.lds + RING_OFF, g, S, E);
            if (BOTH(pb + 0)) GRID_BAR();
        }
        if (IN(pb + 1)) {
            phase_conv(F, l);
#if NAIVE_ATTN
            phase_attn_naive(F, l);
#else
            phase_attn(F, l);
#endif
            phase_m1(F, l);
            if (BOTH(pb + 1)) GRID_BAR();
        }
        if (IN(pb + 2)) { phase_m2(F); if (BOTH(pb + 2)) GRID_BAR(); }
        if (IN(pb + 3)) { phase_m3(F, l); if (BOTH(pb + 3)) GRID_BAR(); }
        if (IN(pb + 4)) {
            static_assert(WS_YM - WS_YC == WS_YA - WS_YM, "branch outputs equally spaced");
            pg8::Gemm g{(const bf16*)(F.ws + WS_YC), (const bf16*)(F.ws + WS_WUP) + (size_t)l * 3 * DM * 1024, WS_YM - WS_YC, (size_t)DM * 1024 * 2, M, DM, 1024, 3};
            pg8::StaticOrder S; S.init(M, DM, F.G, (int)blockIdx.x, 3);
            pg8::EpiMerge E{(const bf16*)(F.ws + WS_Z) + ZC_GT, ZW, DM, (bf16*)(F.ws + WS_MRG), DM};
            pg8::gemm_phase<pg8::EpiMerge>(F.lds + RING_OFF, g, S, E);
            if (BOTH(pb + 4)) GRID_BAR();
        }
        if (IN(pb + 5)) {
            pg8::Gemm g{(const bf16*)(F.ws + WS_MRG), (const bf16*)(F.ws + WS_WOUT) + (size_t)l * DM * DM, 0, 0, M, DM, DM, 1};
            pg8::StaticOrder S; S.init(M, DM, F.G, (int)blockIdx.x, 1);
            pg8::EpiF32 E{(float*)(F.ws + WS_YT), DM};
            pg8::gemm_phase<pg8::EpiF32>(F.lds + RING_OFF, g, S, E);
            if (BOTH(pb + 5)) GRID_BAR();
        }
        if (IN(pb + 6)) { phase_norm1(F, l); if (BOTH(pb + 6)) GRID_BAR(); }
        if (IN(pb + 7)) {
            { pg8::Gemm g{(const bf16*)(F.ws + WS_PB) + (size_t)l * M * PLE, (const bf16*)(F.ws + WS_WPLE) + (size_t)l * DM * PLE, 0, 0, M, DM, PLE, 1};
              pg8::StaticOrder S; S.init(M, DM, F.G, (int)blockIdx.x, 1);
              pg8::EpiBf16 E{(bf16*)(F.ws + WS_E), DM};
              pg8::gemm_phase<pg8::EpiBf16>(F.lds + RING_OFF, g, S, E); }
            VM_WAIT(); __syncthreads();
            { pg8::Gemm g{(const bf16*)(F.ws + WS_XB), (const bf16*)(F.ws + WS_WG) + (size_t)l * DM * DM, 0, 0, M, DM, DM, 1};
              pg8::StaticOrder S; S.init(M, DM, F.G, (int)blockIdx.x, 1);
              pg8::EpiGateMul E{(const bf16*)(F.ws + WS_E), DM, (float*)(F.ws + WS_YT), DM};
              pg8::gemm_phase<pg8::EpiGateMul>(F.lds + RING_OFF, g, S, E); }
            if (BOTH(pb + 7)) GRID_BAR();
        }
        if (IN(pb + 8)) { phase_norm2(F, l); if (BOTH(pb + 8)) GRID_BAR(); }
    }
#undef IN
#undef BOTH
}

extern "C" void kernel_launch(void* const* d_in, const int* in_sizes, int n_in, void* d_out, int out_size, void* d_ws, size_t ws_size, hipStream_t stream) {
    static int grid = 0;
    if (grid == 0) {
        if (n_in != 18 || out_size != M * DM || ws_size < WS_END) { fprintf(stderr, "kernel_launch: unexpected shapes (n_in %d, out %d, ws %zu)\n", n_in, out_size, ws_size); grid = -1; return; }
        int dev = 0, cus = 0, per_cu = 0;
        if (hipGetDevice(&dev) != hipSuccess || hipDeviceGetAttribute(&cus, hipDeviceAttributeMultiprocessorCount, dev) != hipSuccess) { grid = -1; return; }
        if (hipFuncSetAttribute((const void*)fwd, hipFuncAttributeMaxDynamicSharedMemorySize, LDS_BYTES) != hipSuccess) { fprintf(stderr, "kernel_launch: hipFuncSetAttribute failed\n"); grid = -1; return; }
        if (hipOccupancyMaxActiveBlocksPerMultiprocessor(&per_cu, (const void*)fwd, NWAVES * 64, LDS_BYTES) != hipSuccess || per_cu < 1) fprintf(stderr, "kernel_launch: occupancy query says %d\n", per_cu);
        (void)hipGetLastError();
        grid = cus;
    }
    if (grid < 0) return;
    (void)hipMemsetAsync((char*)d_ws + WS_CTL, 0, CTL_ZERO_BYTES, stream);
    Args a{};
    for (int i = 0; i < 18; ++i) a.in[i] = d_in[i];
    a.out = (float*)d_out; a.ws = (unsigned char*)d_ws;
#if MK_ONE_LAUNCH
    a.ph_lo = 0; a.ph_hi = NPH;
    hipLaunchKernelGGL(fwd, dim3(grid), dim3(NWAVES * 64), LDS_BYTES, stream, a);
#else
    for (int ph = 0; ph < NPH; ++ph) { a.ph_lo = ph; a.ph_hi = ph + 1; hipLaunchKernelGGL(fwd, dim3(grid), dim3(NWAVES * 64), LDS_BYTES, stream, a); }
#endif
}
```
